# Optimizing an MI355X kernel written in HIP

```python
import jax, jax.numpy as jnp
from jax import lax
import numpy as np

D_MODEL = 1024
BATCH = 8
SEQ = 2048
DEPTH = 1
DEC_BATCH = 128
DEC_SEQ = 4
PAST_LEN = 16384
PAGE_SIZE = 128

D_CONV = D_MODEL // 2
D_POOL = D_MODEL - D_CONV
D_MIX = D_CONV + D_POOL
CONV_WIDTH = 31
CONV_CTX = CONV_WIDTH - 1
CONV_HEADS = 8
POOL_WINDOWS = (2, 4, 8, 16)
N_POOL_GROUPS = len(POOL_WINDOWS)
POOL_GROUP = D_POOL // N_POOL_GROUPS
POOL_CTX = max(POOL_WINDOWS) - 1
N_MEM = 256
X_HEADS = 4
X_HEAD_DIM = D_MODEL // X_HEADS
D_FF = 4 * D_MODEL
LN_EPS = 1e-5
DN_ALPHA = (2.0 * DEPTH) ** 0.25
DN_BETA = (8.0 * DEPTH) ** -0.25

kernel_name = "hybrid_conv_pool_xattn_decoder_step"


def layer_norm(x, g, b):
    xf = x.astype(jnp.float32)
    mu = jnp.mean(xf, axis=-1, keepdims=True)
    var = jnp.mean(jnp.square(xf - mu), axis=-1, keepdims=True)
    y = (xf - mu) * lax.rsqrt(var + LN_EPS)
    return (y * g.astype(jnp.float32) + b.astype(jnp.float32)).astype(x.dtype)


def group_norm_tokens(x, g, b):
    B, T, C = x.shape
    xf = x.astype(jnp.float32).reshape(B, T, CONV_HEADS, C // CONV_HEADS)
    mu = jnp.mean(xf, axis=-1, keepdims=True)
    var = jnp.mean(jnp.square(xf - mu), axis=-1, keepdims=True)
    y = ((xf - mu) * lax.rsqrt(var + LN_EPS)).reshape(B, T, C)
    return (y * g.astype(jnp.float32) + b.astype(jnp.float32)).astype(x.dtype)


def conv_branch(u, ctx, conv_w, conv_b, gn_g, gn_b):
    u_ext = jnp.concatenate([ctx.astype(u.dtype), u], axis=1)
    y = lax.conv_general_dilated(
        u_ext, conv_w[:, None, :].astype(u.dtype), window_strides=(1,), padding="VALID",
        dimension_numbers=("NWC", "WIO", "NWC"), feature_group_count=D_CONV)
    y = group_norm_tokens(y + conv_b, gn_g, gn_b)
    return jax.nn.silu(y), u_ext[:, -CONV_CTX:]


def pool_branch(p, ctx, pos0, pool_w, pool_scale):
    B, T, _ = p.shape
    p_ext = jnp.concatenate([ctx.astype(p.dtype), p], axis=1)
    L = p_ext.shape[1]
    pf = p_ext.astype(jnp.float32).reshape(B, L, N_POOL_GROUPS, POOL_GROUP)
    csum = jnp.cumsum(pf, axis=1)
    pos = pos0 + jnp.arange(T)
    means = []
    for gi, w in enumerate(POOL_WINDOWS):
        c = csum[:, :, gi]
        c_shift = jnp.pad(c, ((0, 0), (w, 0), (0, 0)))[:, :L]
        win_sum = (c - c_shift)[:, POOL_CTX:]
        count = jnp.minimum(pos + 1, w).astype(jnp.float32)[None, :, None]
        means.append(win_sum / count)
    mean = jnp.stack(means, axis=2)
    delta = (mean - pf[:, POOL_CTX:]).astype(p.dtype)
    mixed = jnp.einsum("btgc,gcd->btgd", delta, pool_w).reshape(B, T, D_POOL)
    return mixed * pool_scale, p_ext[:, -POOL_CTX:]


def mem_kv(mem, xk_w, xv_w):
    B, M, _ = mem.shape
    k = (mem @ xk_w).reshape(B, M, X_HEADS, X_HEAD_DIM)
    v = (mem @ xv_w).reshape(B, M, X_HEADS, X_HEAD_DIM)
    return k, v


def cross_attn(x, k, v, xq_w, xo_w):
    B, T, _ = x.shape
    q = (x @ xq_w).reshape(B, T, X_HEADS, X_HEAD_DIM)
    s = jnp.einsum("bthd,bmhd->bhtm", q, k.astype(q.dtype)).astype(jnp.float32) * (X_HEAD_DIM ** -0.5)
    a = jax.nn.softmax(s, axis=-1).astype(x.dtype)
    o = jnp.einsum("bhtm,bmhd->bthd", a, v.astype(x.dtype)).reshape(B, T, D_MODEL)
    return o @ xo_w


def decoder_layer(x, conv_ctx, pool_ctx, mem_k, mem_v, pos0,
                  w_in, b_in, conv_w, conv_b, gn_g, gn_b, pool_w, pool_scale, w_out,
                  ln1_g, ln1_b, xq_w, xo_w, ln2_g, ln2_b, w1, b1, w2, b2, ln3_g, ln3_b):
    h = x @ w_in + b_in
    a, g, p = jnp.split(h, [D_CONV, 2 * D_CONV], axis=-1)
    u = a * jax.nn.sigmoid(g)
    o_conv, conv_new = conv_branch(u, conv_ctx, conv_w, conv_b, gn_g, gn_b)
    o_pool, pool_new = pool_branch(p, pool_ctx, pos0, pool_w, pool_scale)
    mix = jnp.concatenate([o_conv, o_pool], axis=-1) @ w_out
    x = layer_norm(DN_ALPHA * x + mix, ln1_g, ln1_b)
    x = layer_norm(DN_ALPHA * x + cross_attn(x, mem_k, mem_v, xq_w, xo_w), ln2_g, ln2_b)
    f = jnp.square(jax.nn.relu(x @ w1 + b1)) @ w2 + b2
    x = layer_norm(DN_ALPHA * x + f, ln3_g, ln3_b)
    return x, conv_new, pool_new


def setup_inputs(seed: int = 0) -> dict:
    key = jax.random.key(seed)
    ks = iter(jax.random.split(key, 40))
    nrm = lambda shape, scale: jax.random.normal(next(ks), shape, jnp.float32) * scale
    d_in = 2 * D_CONV + D_POOL
    return {
        "x_prompt": nrm((BATCH, SEQ, D_MODEL), 1.0),
        "x_sample": nrm((DEC_BATCH, DEC_SEQ, D_MODEL), 1.0),
        "mem_prompt": nrm((BATCH, N_MEM, D_MODEL), 1.0),
        "cache_mem_k": nrm((DEPTH, DEC_BATCH, N_MEM, X_HEADS, X_HEAD_DIM), 1.0),
        "cache_mem_v": nrm((DEPTH, DEC_BATCH, N_MEM, X_HEADS, X_HEAD_DIM), DN_BETA),
        "state_conv": nrm((DEPTH, DEC_BATCH, CONV_CTX, D_CONV), 0.5),
        "state_pool": nrm((DEPTH, DEC_BATCH, POOL_CTX, D_POOL), 1.0),
        "w_in": nrm((DEPTH, D_MODEL, d_in), D_MODEL ** -0.5),
        "b_in": nrm((DEPTH, d_in), 0.02),
        "conv_w": nrm((DEPTH, CONV_WIDTH, D_CONV), CONV_WIDTH ** -0.5),
        "conv_b": nrm((DEPTH, D_CONV), 0.02),
        "gn_g": 1.0 + nrm((DEPTH, D_CONV), 0.02),
        "gn_b": nrm((DEPTH, D_CONV), 0.02),
        "pool_w": nrm((DEPTH, N_POOL_GROUPS, POOL_GROUP, POOL_GROUP), POOL_GROUP ** -0.5),
        "pool_scale": 1.0 + nrm((DEPTH, D_POOL), 0.1),
        "w_out": nrm((DEPTH, D_MIX, D_MODEL), D_MIX ** -0.5 * DN_BETA),
        "ln1_g": 1.0 + nrm((DEPTH, D_MODEL), 0.02),
        "ln1_b": nrm((DEPTH, D_MODEL), 0.02),
        "xq_w": nrm((DEPTH, D_MODEL, D_MODEL), D_MODEL ** -0.5),
        "xk_w": nrm((DEPTH, D_MODEL, D_MODEL), D_MODEL ** -0.5),
        "xv_w": nrm((DEPTH, D_MODEL, D_MODEL), D_MODEL ** -0.5 * DN_BETA),
        "xo_w": nrm((DEPTH, D_MODEL, D_MODEL), D_MODEL ** -0.5 * DN_BETA),
        "ln2_g": 1.0 + nrm((DEPTH, D_MODEL), 0.02),
        "ln2_b": nrm((DEPTH, D_MODEL), 0.02),
        "w1": nrm((DEPTH, D_MODEL, D_FF), D_MODEL ** -0.5),
        "b1": nrm((DEPTH, D_FF), 0.02),
        "w2": nrm((DEPTH, D_FF, D_MODEL), D_FF ** -0.5 * DN_BETA),
        "b2": nrm((DEPTH, D_MODEL), 0.02),
        "ln3_g": 1.0 + nrm((DEPTH, D_MODEL), 0.02),
        "ln3_b": nrm((DEPTH, D_MODEL), 0.02),
    }


def reference(x_prompt, x_sample, mem_prompt, cache_mem_k, cache_mem_v, state_conv, state_pool,
              w_in, b_in, conv_w, conv_b, gn_g, gn_b, pool_w, pool_scale, w_out,
              ln1_g, ln1_b, xq_w, xk_w, xv_w, xo_w, ln2_g, ln2_b, w1, b1, w2, b2, ln3_g, ln3_b):
    n_prompt = x_prompt.shape[0]
    hp, hs = x_prompt, x_sample
    mk_p, mv_p, conv_p, conv_s, pool_p, pool_s = [], [], [], [], [], []
    for l in range(DEPTH):
        lw = (w_in[l], b_in[l], conv_w[l], conv_b[l], gn_g[l], gn_b[l], pool_w[l], pool_scale[l],
              w_out[l], ln1_g[l], ln1_b[l], xq_w[l], xo_w[l], ln2_g[l], ln2_b[l],
              w1[l], b1[l], w2[l], b2[l], ln3_g[l], ln3_b[l])
        k_p, v_p = mem_kv(mem_prompt, xk_w[l], xv_w[l])
        hp, c_p, q_p = decoder_layer(
            hp, jnp.zeros((n_prompt, CONV_CTX, D_CONV), hp.dtype),
            jnp.zeros((n_prompt, POOL_CTX, D_POOL), hp.dtype), k_p, v_p, 0, *lw)
        hs, c_s, q_s = decoder_layer(
            hs, state_conv[l], state_pool[l], cache_mem_k[l], cache_mem_v[l], PAST_LEN, *lw)
        mk_p.append(k_p)
        mv_p.append(v_p)
        conv_p.append(c_p)
        conv_s.append(c_s)
        pool_p.append(q_p)
        pool_s.append(q_s)
    return (hp, hs, jnp.stack(mk_p), jnp.stack(mv_p), jnp.stack(conv_p), jnp.stack(conv_s),
            jnp.stack(pool_p), jnp.stack(pool_s))
```

```cpp
#include <hip/hip_runtime.h>
#include <hip/hip_cooperative_groups.h>
#include <cstdio>
#include <cstdint>
namespace cg = cooperative_groups;
namespace pg8 {
#define PG8_LAS __attribute__((address_space(3)))
typedef unsigned short bf16_t;
typedef short bf16x8 __attribute__((ext_vector_type(8)));
typedef float f32x4 __attribute__((ext_vector_type(4)));
typedef unsigned u32x4 __attribute__((ext_vector_type(4)));
constexpr int BM = 256, BK = 64, HALF = 128, HTB = HALF * BK * 2  , STAGE_BYTES = 8 * HTB, NXCD = 8, WGM = 8;

__host__ __device__ __forceinline__ int lds_byte(int r, int c) { const int st = (r >> 4) * 2 + (c >> 5), rr = r & 15, cc = c & 31, ob = rr * 64 + cc * 2; return st * 1024 + (ob ^ (((ob >> 9) & 1) << 5)); }
__host__ __device__ __forceinline__ void stage_rc(int b, int& R, int& C) { const int st = b / 1024, sb = b % 1024, swz = sb ^ (((sb >> 9) & 1) << 5); R = (st >> 1) * 16 + swz / 64; C = (st & 1) * 32 + (swz % 64) / 2; }
__host__ __device__ __forceinline__ int perm32(int rho) { const int n = rho >> 4, i = rho & 15; return 8 * (i >> 2) + 4 * n + (i & 3); }

struct Unit { int pm, pn; };
struct Gemm { const bf16_t* A; const bf16_t* Bt; int M, N, K; };

struct StaticOrder {
    int nM, nN, nwg, G, c;
    __host__ __device__ void init(int M, int N, int G_, int c_) { nM = M / BM; nN = N / BM; nwg = nM * nN; G = G_; c = c_; }
    __host__ __device__ bool next(int i, Unit& u) const {
        const long L = (long)i * G + c; if (L >= nwg) return false;
        int wgid = (int)L; { const int q = nwg / NXCD, r = nwg % NXCD, xcd = wgid % NXCD, off = wgid / NXCD; wgid = (xcd < r ? xcd * (q + 1) : r * (q + 1) + (xcd - r) * q) + off; }
        const int nig = WGM * nN, gid = wgid / nig, fm = gid * WGM, gsz = (nM - fm) < WGM ? (nM - fm) : WGM;
        u.pm = fm + ((wgid % nig) % gsz); u.pn = (wgid % nig) / gsz; return true;
    }
    __device__ __forceinline__ void a_ready(const Unit&) const {}
    __device__ __forceinline__ void done(const Unit&) const {}
};

__device__ __forceinline__ unsigned cvt_pk_bf16(float lo, float hi) { unsigned r; asm volatile("v_cvt_pk_bf16_f32 %0, %1, %2" : "=v"(r) : "v"(lo), "v"(hi)); return r; }
typedef float f32x2 __attribute__((ext_vector_type(2)));
template <class Epi, class Sched, bool ALIGN_EPI = false, bool SP2 = false>
__device__ __forceinline__ void gemm_phase(PG8_LAS unsigned char* lds, const Gemm g, const Sched& S, const Epi& E) {
    const int tid = threadIdx.x, wid = __builtin_amdgcn_readfirstlane(tid >> 6), lane = tid & 63, wr = wid >> 2, wc = wid & 3, fr = lane & 15, fq = lane >> 4;
    const int K = g.K, nt = K / BK;
    unsigned voffA[2], voffB[2];
#pragma unroll
    for (int i = 0; i < 2; ++i) { int R, C; stage_rc(tid * 16 + i * 8192, R, C); const int Rb = Epi::PERM ? ((R & ~31) + perm32(R & 31)) : R;
        voffA[i] = (unsigned)(R * K + C) * 2u; voffB[i] = (unsigned)(Rb * K + C) * 2u; }
    const size_t kstep = (size_t)(BK * 2);
    const size_t hstep = (size_t)HALF * K * 2;
    const size_t tstep = 2 * hstep;
    const unsigned ldsw = (unsigned)wid * 1024u;
    const int aoff = lds_byte(wr * 64 + fr, fq * 8), boff = lds_byte(wc * 32 + fr, fq * 8);
#define PG8_SA(b, h) (((b) * 2 + (h)) * HTB)
#define PG8_SB(b, h) ((4 + (b) * 2 + (h)) * HTB)
#define PG8_STAGE(bufoff, gbase, voff) do { _Pragma("unroll") for (int _i = 0; _i < 2; ++_i) \
        __builtin_amdgcn_global_load_lds((const unsigned*)((const char*)(gbase) + (voff)[_i]), (PG8_LAS unsigned*)(lds + (bufoff) + ldsw + _i * 8192), 16, 0, 0); } while (0)
#define PG8_LDA(dst, b, h) do { _Pragma("unroll") for (int m = 0; m < 4; ++m) _Pragma("unroll") for (int k = 0; k < 2; ++k) dst[m][k] = *(const PG8_LAS bf16x8*)(lds + PG8_SA(b, h) + aoff + m * 2048 + k * 1024); } while (0)
#define PG8_LDB(dst, b, h) do { _Pragma("unroll") for (int n = 0; n < 2; ++n) _Pragma("unroll") for (int k = 0; k < 2; ++k) dst[n][k] = *(const PG8_LAS bf16x8*)(lds + PG8_SB(b, h) + boff + n * 2048 + k * 1024); } while (0)
#define PG8_MMA(ai, bj, At, Bt) do { __builtin_amdgcn_s_setprio(1); _Pragma("unroll") for (int m = 0; m < 4; ++m) _Pragma("unroll") for (int n = 0; n < 2; ++n) _Pragma("unroll") for (int k = 0; k < 2; ++k) \
        acc[ai][bj][m][n] = __builtin_amdgcn_mfma_f32_16x16x32_bf16(Bt[n][k], At[m][k], acc[ai][bj][m][n], 0, 0, 0); __builtin_amdgcn_s_setprio(0); } while (0)
#define PG8_WAIT_V(n) asm volatile("s_waitcnt vmcnt(" #n ")" ::: "memory")
#define PG8_WAIT_L(n) asm volatile("s_waitcnt lgkmcnt(" #n ")" ::: "memory")
#define PG8_BAR __builtin_amdgcn_s_barrier()
#define PG8_SCHED __builtin_amdgcn_sched_barrier(0)
    Unit cur, nxt; int ui = 0;
    if (!S.next(0, cur)) return;
    f32x4 acc[2][2][4][2];
#pragma unroll
    for (int a = 0; a < 2; ++a)
#pragma unroll
        for (int b = 0; b < 2; ++b)
#pragma unroll
            for (int m = 0; m < 4; ++m)
#pragma unroll
                for (int n = 0; n < 2; ++n) acc[a][b][m][n] = (f32x4){0.f, 0.f, 0.f, 0.f};
    bf16x8 At[4][2], B0[2][2], B1[2][2];
    const char* cA = (const char*)g.A + (size_t)cur.pm * tstep; const char* cB = (const char*)g.Bt + (size_t)cur.pn * tstep;
    S.a_ready(cur);
    if constexpr (SP2) {
        PG8_STAGE(PG8_SB(0, 0), cB, voffB); PG8_STAGE(PG8_SB(0, 1), cB + hstep, voffB); PG8_STAGE(PG8_SA(0, 0), cA, voffA); PG8_STAGE(PG8_SA(0, 1), cA + hstep, voffA);
        if (wr == 1) PG8_BAR;
        PG8_WAIT_V(2); PG8_BAR;
        PG8_STAGE(PG8_SB(1, 0), cB + kstep, voffB); PG8_STAGE(PG8_SA(1, 0), cA + kstep, voffA); PG8_STAGE(PG8_SB(1, 1), cB + hstep + kstep, voffB);
        PG8_WAIT_V(6); PG8_BAR;
    } else {
        PG8_STAGE(PG8_SB(0, 0), cB, voffB); PG8_STAGE(PG8_SA(0, 0), cA, voffA); PG8_STAGE(PG8_SB(0, 1), cB + hstep, voffB); PG8_STAGE(PG8_SA(0, 1), cA + hstep, voffA);
        if (wr == 1) PG8_BAR;
        PG8_WAIT_V(4); PG8_BAR;
        PG8_STAGE(PG8_SB(1, 0), cB + kstep, voffB); PG8_STAGE(PG8_SA(1, 0), cA + kstep, voffA); PG8_STAGE(PG8_SB(1, 1), cB + hstep + kstep, voffB);
        PG8_WAIT_V(6); PG8_BAR;
    }
    for (;;) {
        const bool has_next = S.next(ui + 1, nxt);
        const char* nA = has_next ? (const char*)g.A + (size_t)nxt.pm * tstep : cA; const char* nB = has_next ? (const char*)g.Bt + (size_t)nxt.pn * tstep : cB;
        for (int t = 0; t < nt; t += 2) {
            const bool last = (t == nt - 2);
            const char* a1 = cA + (size_t)(t + 1) * kstep;
            const char* a2 = last ? nA : cA + (size_t)(t + 2) * kstep; const char* b2 = last ? nB : cB + (size_t)(t + 2) * kstep;
            const char* a3 = a2 + kstep; const char* b3 = b2 + kstep;
            if (last && has_next) S.a_ready(nxt);
            if constexpr (SP2) {
            PG8_LDB(B0, 0, 0); PG8_LDB(B1, 0, 1); PG8_SCHED; PG8_LDA(At, 0, 0); PG8_STAGE(PG8_SA(1, 1), a1 + hstep, voffA);
            PG8_WAIT_V(8); PG8_WAIT_L(0); PG8_BAR; PG8_MMA(0, 0, At, B0); PG8_MMA(0, 1, At, B1); PG8_BAR; PG8_SCHED;
            PG8_LDA(At, 0, 1); PG8_STAGE(PG8_SB(0, 0), b2, voffB); PG8_STAGE(PG8_SB(0, 1), b2 + hstep, voffB); PG8_STAGE(PG8_SA(0, 0), a2, voffA);
            PG8_WAIT_V(8); PG8_WAIT_L(0); PG8_BAR; PG8_MMA(1, 0, At, B0); PG8_MMA(1, 1, At, B1); PG8_BAR; PG8_SCHED;
            PG8_LDB(B0, 1, 0); PG8_LDB(B1, 1, 1); PG8_SCHED; PG8_LDA(At, 1, 0); PG8_STAGE(PG8_SA(0, 1), a2 + hstep, voffA);
            PG8_WAIT_V(8); PG8_WAIT_L(0); PG8_BAR; PG8_MMA(0, 0, At, B0); PG8_MMA(0, 1, At, B1); PG8_BAR; PG8_SCHED;
            PG8_LDA(At, 1, 1); PG8_STAGE(PG8_SB(1, 0), b3, voffB); PG8_STAGE(PG8_SB(1, 1), b3 + hstep, voffB); PG8_STAGE(PG8_SA(1, 0), a3, voffA);
            PG8_WAIT_V(8); PG8_WAIT_L(0); PG8_BAR; PG8_MMA(1, 0, At, B0); PG8_MMA(1, 1, At, B1); PG8_BAR; PG8_SCHED;
            } else {
            PG8_LDB(B0, 0, 0); PG8_SCHED; PG8_LDA(At, 0, 0); PG8_STAGE(PG8_SA(1, 1), a1 + hstep, voffA);
            PG8_WAIT_L(8); PG8_BAR; PG8_WAIT_L(0); PG8_MMA(0, 0, At, B0); PG8_BAR; PG8_SCHED;
            PG8_LDB(B1, 0, 1); PG8_STAGE(PG8_SB(0, 0), b2, voffB);
            PG8_BAR; PG8_WAIT_L(0); PG8_MMA(0, 1, At, B1); PG8_BAR;
            PG8_LDA(At, 0, 1); PG8_STAGE(PG8_SA(0, 0), a2, voffA);
            PG8_BAR; PG8_WAIT_L(0); PG8_MMA(1, 0, At, B0); PG8_BAR; PG8_SCHED;
            PG8_STAGE(PG8_SB(0, 1), b2 + hstep, voffB);
            PG8_WAIT_V(6); PG8_BAR; PG8_MMA(1, 1, At, B1); PG8_BAR;
            PG8_LDB(B0, 1, 0); PG8_SCHED; PG8_LDA(At, 1, 0); PG8_STAGE(PG8_SA(0, 1), a2 + hstep, voffA);
            PG8_WAIT_L(8); PG8_BAR; PG8_WAIT_L(0); PG8_MMA(0, 0, At, B0); PG8_BAR; PG8_SCHED;
            PG8_LDB(B1, 1, 1); PG8_STAGE(PG8_SB(1, 0), b3, voffB);
            PG8_BAR; PG8_WAIT_L(0); PG8_MMA(0, 1, At, B1); PG8_BAR;
            PG8_LDA(At, 1, 1); PG8_STAGE(PG8_SA(1, 0), a3, voffA);
            PG8_BAR; PG8_WAIT_L(0); PG8_MMA(1, 0, At, B0); PG8_BAR; PG8_SCHED;
            PG8_STAGE(PG8_SB(1, 1), b3 + hstep, voffB);
            PG8_WAIT_V(6); PG8_BAR; PG8_MMA(1, 1, At, B1); PG8_BAR;
            }
        }
        if constexpr (ALIGN_EPI) { if (wr == 0) PG8_BAR; }
        if constexpr (!Epi::AFTER_DRAIN) { E(acc, cur, wr, wc, fr, fq); S.done(cur); }
        if (!has_next) break;
#pragma unroll
        for (int a = 0; a < 2; ++a)
#pragma unroll
            for (int b = 0; b < 2; ++b)
#pragma unroll
                for (int m = 0; m < 4; ++m)
#pragma unroll
                    for (int n = 0; n < 2; ++n) acc[a][b][m][n] = (f32x4){0.f, 0.f, 0.f, 0.f};
        cur = nxt; cA = nA; cB = nB; ++ui;
        if constexpr (ALIGN_EPI) { if (wr == 1) PG8_BAR; }
    }
    PG8_WAIT_V(0);
    if constexpr (!ALIGN_EPI) { if (wr == 0) PG8_BAR; }
    PG8_BAR;
    if constexpr (Epi::AFTER_DRAIN) { E.fused(acc, cur, wr, wc, fr, fq, lds, wid, lane); S.done(cur); }
#undef PG8_SA
#undef PG8_SB
#undef PG8_STAGE
#undef PG8_LDA
#undef PG8_LDB
#undef PG8_MMA
#undef PG8_WAIT_V
#undef PG8_WAIT_L
#undef PG8_BAR
#undef PG8_SCHED
}
}

#ifndef MK_PER_PHASE
#define MK_PER_PHASE 0
#endif
#define LAS __attribute__((address_space(3)))
using pg8::bf16_t; using pg8::f32x4; using pg8::u32x4; using pg8::bf16x8; using pg8::Unit;
typedef unsigned u32x2 __attribute__((ext_vector_type(2)));
typedef float f32x2v __attribute__((ext_vector_type(2)));
typedef __bf16 b16x2v __attribute__((ext_vector_type(2)));
typedef float f32x16 __attribute__((ext_vector_type(16)));
typedef short s16x4 __attribute__((ext_vector_type(4)));

constexpr int DM = 1024, SEQ = 2048, NBATCH = 8, NPT = NBATCH * SEQ, DECB = 128, DECS = 4, NST = DECB * DECS, MT = NPT + NST;
constexpr int NMEM = 256, MEMROWS = NBATCH * NMEM, DFF = 4096, DIN = 1536, DC = 512;
constexpr float LN_EPS = 1e-5f, DN_ALPHA = 1.18920711500272f;
constexpr int NPHASE = 10;

constexpr size_t OY = 0, OMK = (size_t)MT * DM, OMV = OMK + (size_t)MEMROWS * DM, OCP = OMV + (size_t)MEMROWS * DM, OCS = OCP + (size_t)NBATCH * 30 * 512,
                 OPP = OCS + (size_t)DECB * 30 * 512, OPS = OPP + (size_t)NBATCH * 15 * 512, OEND = OPS + (size_t)DECB * 15 * 512;
constexpr size_t MiB = 1u << 20;
constexpr size_t WS_CTL = 0, CTL_ZERO_BYTES = 512 * 1024;
constexpr size_t WS_WIN = 2 * MiB, WS_WKV = 5 * MiB, WS_WOUT = 9 * MiB, WS_WQ = 11 * MiB, WS_WO = 13 * MiB, WS_W1 = 15 * MiB, WS_W2 = 23 * MiB;
constexpr size_t WS_KB = 31 * MiB, WS_VT = 35 * MiB, WS_MB = 39 * MiB;
constexpr size_t WS_XB = 44 * MiB, WS_U = 77 * MiB, WS_P = WS_U + (size_t)MT * DC * 2, WS_MIX = 110 * MiB, WS_R1B = 143 * MiB, WS_Q = 176 * MiB, WS_O = 209 * MiB;
constexpr size_t WS_R1 = 242 * MiB, WS_R2 = 308 * MiB, WS_R2B = 374 * MiB, WS_END = 407 * MiB;
constexpr size_t WS_H = 44 * MiB;
static_assert(WS_H + (size_t)MT * DFF * 2 <= WS_Q, "H overlay");
constexpr int CF_ST1 = 0, CF_ST2 = 34816, CF_C1Q = 69632, CF_C2Q = 70656, CF_C1H = 71680, CF_C2H = 75776, CF_END = 79872;
static_assert(CF_END * 4 <= (int)CTL_ZERO_BYTES && MT * 2 <= CF_ST2, "ctl");

constexpr int LDS_BYTES = 131072 + 4096;

__device__ __forceinline__ unsigned pk2(float lo, float hi) { f32x2v v = {lo, hi}; b16x2v b = __builtin_convertvector(v, b16x2v); return __builtin_bit_cast(unsigned, b); }
__device__ __forceinline__ float bflo(unsigned v) { return __uint_as_float(v << 16); }
__device__ __forceinline__ float bfhi(unsigned v) { return __uint_as_float(v & 0xffff0000u); }
__device__ __forceinline__ float wave_sum(float v) {
#pragma unroll
    for (int o = 1; o < 64; o <<= 1) v += __shfl_xor(v, o);
    return v;
}
__device__ __forceinline__ float wave_max(float v) {
#pragma unroll
    for (int o = 1; o < 64; o <<= 1) v = fmaxf(v, __shfl_xor(v, o));
    return v;
}
__device__ __forceinline__ float fsigmoid(float x) { return __builtin_amdgcn_rcpf(1.0f + __expf(-x)); }

struct Args {
    const float* in[30]; float* outp; unsigned char* ws; int ph_lo, ph_hi;
    __device__ __forceinline__ const float* x_prompt() const { return in[0]; }
    __device__ __forceinline__ const float* x_sample() const { return in[1]; }
    __device__ __forceinline__ const float* mem_prompt() const { return in[2]; }
    __device__ __forceinline__ const float* cache_k() const { return in[3]; }
    __device__ __forceinline__ const float* cache_v() const { return in[4]; }
    __device__ __forceinline__ const float* state_conv() const { return in[5]; }
    __device__ __forceinline__ const float* state_pool() const { return in[6]; }
    __device__ __forceinline__ const float* w_in() const { return in[7]; }
    __device__ __forceinline__ const float* b_in() const { return in[8]; }
    __device__ __forceinline__ const float* conv_w() const { return in[9]; }
    __device__ __forceinline__ const float* conv_b() const { return in[10]; }
    __device__ __forceinline__ const float* gn_g() const { return in[11]; }
    __device__ __forceinline__ const float* gn_b() const { return in[12]; }
    __device__ __forceinline__ const float* pool_w() const { return in[13]; }
    __device__ __forceinline__ const float* pool_scale() const { return in[14]; }
    __device__ __forceinline__ const float* w_out() const { return in[15]; }
    __device__ __forceinline__ const float* ln1_g() const { return in[16]; }
    __device__ __forceinline__ const float* ln1_b() const { return in[17]; }
    __device__ __forceinline__ const float* xq_w() const { return in[18]; }
    __device__ __forceinline__ const float* xk_w() const { return in[19]; }
    __device__ __forceinline__ const float* xv_w() const { return in[20]; }
    __device__ __forceinline__ const float* xo_w() const { return in[21]; }
    __device__ __forceinline__ const float* ln2_g() const { return in[22]; }
    __device__ __forceinline__ const float* ln2_b() const { return in[23]; }
    __device__ __forceinline__ const float* w1() const { return in[24]; }
    __device__ __forceinline__ const float* b1() const { return in[25]; }
    __device__ __forceinline__ const float* w2() const { return in[26]; }
    __device__ __forceinline__ const float* b2() const { return in[27]; }
    __device__ __forceinline__ const float* ln3_g() const { return in[28]; }
    __device__ __forceinline__ const float* ln3_b() const { return in[29]; }
    __device__ __forceinline__ float* out() const { return outp; }
    __device__ __forceinline__ float* ctl() const { return (float*)(ws + WS_CTL); }
    __device__ __forceinline__ bf16_t* Win_t() const { return (bf16_t*)(ws + WS_WIN); }
    __device__ __forceinline__ bf16_t* Wkv_t() const { return (bf16_t*)(ws + WS_WKV); }
    __device__ __forceinline__ bf16_t* Wout_t() const { return (bf16_t*)(ws + WS_WOUT); }
    __device__ __forceinline__ bf16_t* Wq_t() const { return (bf16_t*)(ws + WS_WQ); }
    __device__ __forceinline__ bf16_t* Wo_t() const { return (bf16_t*)(ws + WS_WO); }
    __device__ __forceinline__ bf16_t* W1_t() const { return (bf16_t*)(ws + WS_W1); }
    __device__ __forceinline__ bf16_t* W2_t() const { return (bf16_t*)(ws + WS_W2); }
    __device__ __forceinline__ bf16_t* KB() const { return (bf16_t*)(ws + WS_KB); }
    __device__ __forceinline__ bf16_t* VT() const { return (bf16_t*)(ws + WS_VT); }
    __device__ __forceinline__ bf16_t* MB() const { return (bf16_t*)(ws + WS_MB); }
    __device__ __forceinline__ bf16_t* XB() const { return (bf16_t*)(ws + WS_XB); }
    __device__ __forceinline__ bf16_t* U() const { return (bf16_t*)(ws + WS_U); }
    __device__ __forceinline__ bf16_t* P() const { return (bf16_t*)(ws + WS_P); }
    __device__ __forceinline__ bf16_t* MIX() const { return (bf16_t*)(ws + WS_MIX); }
    __device__ __forceinline__ bf16_t* R1B() const { return (bf16_t*)(ws + WS_R1B); }
    __device__ __forceinline__ bf16_t* Q() const { return (bf16_t*)(ws + WS_Q); }
    __device__ __forceinline__ bf16_t* O() const { return (bf16_t*)(ws + WS_O); }
    __device__ __forceinline__ bf16_t* R2B() const { return (bf16_t*)(ws + WS_R2B); }
    __device__ __forceinline__ bf16_t* H() const { return (bf16_t*)(ws + WS_H); }
    __device__ __forceinline__ float* R1() const { return (float*)(ws + WS_R1); }
    __device__ __forceinline__ float* R2() const { return (float*)(ws + WS_R2); }
};

__device__ __forceinline__ int win_dest(int n) {
    if (n < 512) return 32 * (n >> 4) + (n & 15);
    if (n < 1024) { const int c = n - 512; return 32 * (c >> 4) + 16 + (c & 15); }
    return n;
}
template <int MODE>
__device__ __forceinline__ void tr_item(const float* __restrict__ W, int N, bf16_t* WT, int ldk, int row_off, LAS float* scr, int kb, int nb, int lane,
                                        const float* g, const float* b, float* c1, float* c2) {
    const int k0 = 64 * kb, n0 = 32 * nb;
#pragma unroll 8
    for (int i = 0; i < 32; ++i) { const int kk = 2 * i + (lane >> 5); scr[kk * 33 + (lane & 31)] = W[(size_t)(k0 + kk) * N + n0 + (lane & 31)]; }
    asm volatile("s_waitcnt lgkmcnt(0)" ::: "memory");
    if (MODE == 2) {
        const float* vec = (lane < 32) ? g : b; float s = 0.f;
#pragma unroll 8
        for (int k = 0; k < 64; ++k) s += vec[k0 + k] * scr[k * 33 + (lane & 31)];
        atomicAdd(((lane < 32) ? c1 : c2) + n0 + (lane & 31), s);
    }
    const int c = lane & 7;
    float gs[8];
#pragma unroll
    for (int i = 0; i < 8; ++i) gs[i] = (MODE == 2) ? g[k0 + 8 * c + i] : 1.0f;
#pragma unroll
    for (int j = 0; j < 4; ++j) { const int n = (lane >> 3) + 8 * j; const LAS float* s = scr + (8 * c) * 33 + n;
        u32x4 o; o.x = pk2(s[0 * 33] * gs[0], s[1 * 33] * gs[1]); o.y = pk2(s[2 * 33] * gs[2], s[3 * 33] * gs[3]); o.z = pk2(s[4 * 33] * gs[4], s[5 * 33] * gs[5]); o.w = pk2(s[6 * 33] * gs[6], s[7 * 33] * gs[7]);
        const int dr = (MODE == 1) ? win_dest(n0 + n) : (n0 + n);
        *(u32x4*)(WT + (size_t)(row_off + dr) * ldk + k0 + 8 * c) = o; }
    asm volatile("s_waitcnt lgkmcnt(0)" ::: "memory");
}
__device__ __forceinline__ void poolfold_item(const Args& p, int item, int lane) {
    const int g = item >> 8, nb = (item >> 3) & 31, cb = item & 7;
    const int n = nb * 32 + (lane & 31), c0 = cb * 16 + (lane >> 5) * 8;
    float acc[8];
#pragma unroll
    for (int j = 0; j < 8; ++j) acc[j] = 0.f;
    const float* pw = p.pool_w() + (size_t)g * 16384 + (size_t)c0 * 128;
#pragma unroll 4
    for (int d = 0; d < 128; ++d) {
        const float wv = p.w_out()[(size_t)(512 + 128 * g + d) * DM + n] * p.pool_scale()[128 * g + d];
#pragma unroll
        for (int j = 0; j < 8; ++j) acc[j] = fmaf(pw[j * 128 + d], wv, acc[j]);
    }
    u32x4 o; o.x = pk2(acc[0], acc[1]); o.y = pk2(acc[2], acc[3]); o.z = pk2(acc[4], acc[5]); o.w = pk2(acc[6], acc[7]);
    *(u32x4*)(p.Wout_t() + (size_t)n * DM + 512 + 128 * g + c0) = o;
}
__device__ __forceinline__ void row_to_bf16(const float* xrow, bf16_t* orow, int lane) {
    const f32x4* xr = (const f32x4*)xrow + lane; unsigned long long* o8 = (unsigned long long*)orow + lane;
    f32x4 v[4];
#pragma unroll
    for (int j = 0; j < 4; ++j) v[j] = xr[64 * j];
#pragma unroll
    for (int j = 0; j < 4; ++j) o8[64 * j] = (unsigned long long)pk2(v[j].x, v[j].y) | ((unsigned long long)pk2(v[j].z, v[j].w) << 32);
}
__device__ __forceinline__ void p0_prologue(const Args& p, LAS unsigned char* lds, int G, int bid, int tid) {
    const int lane = tid & 63, wave = tid >> 6;
    LAS float* scr = (LAS float*)(lds + wave * 16384);
    const int gw = bid * 8 + wave, NGW = G * 8;
    constexpr int I_IN = 16 * 48, I_K = 16 * 32, I_V = I_K, I_OUT = 8 * 32, I_Q = I_K, I_O = I_K, I_1 = 16 * 128, I_2 = 64 * 32, I_PF = 1024;
    constexpr int NITEMS = I_IN + I_K + I_V + I_OUT + I_Q + I_O + I_1 + I_2 + I_PF;
    for (int it = gw; it < NITEMS; it += NGW) {
        int r = it;
        if (r < I_PF) { poolfold_item(p, r, lane); continue; } r -= I_PF;
        if (r < I_IN) { tr_item<1>(p.w_in(), DIN, p.Win_t(), DM, 0, scr, r / 48, r % 48, lane, nullptr, nullptr, nullptr, nullptr); continue; } r -= I_IN;
        if (r < I_K) { tr_item<0>(p.xk_w(), DM, p.Wkv_t(), DM, 0, scr, r / 32, r % 32, lane, nullptr, nullptr, nullptr, nullptr); continue; } r -= I_K;
        if (r < I_V) { tr_item<0>(p.xv_w(), DM, p.Wkv_t(), DM, DM, scr, r / 32, r % 32, lane, nullptr, nullptr, nullptr, nullptr); continue; } r -= I_V;
        if (r < I_OUT) { tr_item<0>(p.w_out(), DM, p.Wout_t(), DM, 0, scr, r / 32, r % 32, lane, nullptr, nullptr, nullptr, nullptr); continue; } r -= I_OUT;
        if (r < I_Q) { tr_item<2>(p.xq_w(), DM, p.Wq_t(), DM, 0, scr, r / 32, r % 32, lane, p.ln1_g(), p.ln1_b(), p.ctl() + CF_C1Q, p.ctl() + CF_C2Q); continue; } r -= I_Q;
        if (r < I_O) { tr_item<0>(p.xo_w(), DM, p.Wo_t(), DM, 0, scr, r / 32, r % 32, lane, nullptr, nullptr, nullptr, nullptr); continue; } r -= I_O;
        if (r < I_1) { tr_item<2>(p.w1(), DFF, p.W1_t(), DM, 0, scr, r / 128, r % 128, lane, p.ln2_g(), p.ln2_b(), p.ctl() + CF_C1H, p.ctl() + CF_C2H); continue; } r -= I_1;
        tr_item<0>(p.w2(), DM, p.W2_t(), DFF, 0, scr, r / 32, r % 32, lane, nullptr, nullptr, nullptr, nullptr);
    }
    for (int m = gw; m < MT + MEMROWS; m += NGW) {
        if (m < NPT) row_to_bf16(p.x_prompt() + (size_t)m * DM, p.XB() + (size_t)m * DM, lane);
        else if (m < MT) row_to_bf16(p.x_sample() + (size_t)(m - NPT) * DM, p.XB() + (size_t)m * DM, lane);
        else row_to_bf16(p.mem_prompt() + (size_t)(m - MT) * DM, p.MB() + (size_t)(m - MT) * DM, lane);
    }
    const int gt = bid * 512 + tid, NT = G * 512;
    for (int i = gt; i < DECB * 3328; i += NT) { const int sb = i / 3328, o = i % 3328; ((f32x4*)(p.out() + OCS + (size_t)sb * 15360))[o] = ((const f32x4*)(p.state_conv() + (size_t)sb * 15360 + 2048))[o]; }
    for (int i = gt; i < DECB * 1408; i += NT) { const int sb = i / 1408, o = i % 1408; ((f32x4*)(p.out() + OPS + (size_t)sb * 7680))[o] = ((const f32x4*)(p.state_pool() + (size_t)sb * 7680 + 2048))[o]; }
}

struct EpiIn {
    static constexpr bool PERM = false, AFTER_DRAIN = false;
    const float* b_in; bf16_t* U; bf16_t* P; float* out;
    __device__ __forceinline__ void operator()(const f32x4 (&acc)[2][2][4][2], const Unit& u, int wr, int wc, int fr, int fq) const {
        if (u.pn < 4) {
#pragma unroll
            for (int bj = 0; bj < 2; ++bj) {
                const int ch = 16 * (8 * u.pn + 4 * bj + wc) + 4 * fq;
                const f32x4 ba = *(const f32x4*)(b_in + ch), bg = *(const f32x4*)(b_in + 512 + ch);
#pragma unroll
                for (int ai = 0; ai < 2; ++ai)
#pragma unroll
                    for (int m = 0; m < 4; ++m) {
                        const int row = u.pm * 256 + ai * 128 + wr * 64 + m * 16 + fr;
                        const f32x4 av = acc[ai][bj][m][0] + ba, gv = acc[ai][bj][m][1] + bg; f32x4 uv;
#pragma unroll
                        for (int e = 0; e < 4; ++e) uv[e] = av[e] * fsigmoid(gv[e]);
                        u32x2 w; w.x = pk2(uv[0], uv[1]); w.y = pk2(uv[2], uv[3]);
                        *(u32x2*)(U + (size_t)row * DC + ch) = w;
                        if (row < NPT) { const int t = row & (SEQ - 1); if (t >= SEQ - 30) *(f32x4*)(out + OCP + ((size_t)(row >> 11) * 30 + (t - (SEQ - 30))) * 512 + ch) = uv; }
                        else { const int s = row - NPT; *(f32x4*)(out + OCS + ((size_t)(s >> 2) * 30 + 26 + (s & 3)) * 512 + ch) = uv; }
                    }
            }
        } else {
#pragma unroll
            for (int bj = 0; bj < 2; ++bj)
#pragma unroll
                for (int n = 0; n < 2; ++n) {
                    const int pc = 256 * (u.pn - 4) + 128 * bj + 32 * wc + 16 * n + 4 * fq;
                    const f32x4 bp = *(const f32x4*)(b_in + 1024 + pc);
#pragma unroll
                    for (int ai = 0; ai < 2; ++ai)
#pragma unroll
                        for (int m = 0; m < 4; ++m) {
                            const int row = u.pm * 256 + ai * 128 + wr * 64 + m * 16 + fr;
                            const f32x4 pv = acc[ai][bj][m][n] + bp;
                            u32x2 w; w.x = pk2(pv[0], pv[1]); w.y = pk2(pv[2], pv[3]);
                            *(u32x2*)(P + (size_t)row * DC + pc) = w;
                            if (row < NPT) { const int t = row & (SEQ - 1); if (t >= SEQ - 15) *(f32x4*)(out + OPP + ((size_t)(row >> 11) * 15 + (t - (SEQ - 15))) * 512 + pc) = pv; }
                            else { const int s = row - NPT; *(f32x4*)(out + OPS + ((size_t)(s >> 2) * 15 + 11 + (s & 3)) * 512 + pc) = pv; }
                        }
                }
        }
    }
};
struct EpiKV {
    static constexpr bool PERM = false, AFTER_DRAIN = false;
    float* out; bf16_t* KB; bf16_t* VT;
    __device__ __forceinline__ void operator()(const f32x4 (&acc)[2][2][4][2], const Unit& u, int wr, int wc, int fr, int fq) const {
#pragma unroll
        for (int bj = 0; bj < 2; ++bj)
#pragma unroll
            for (int n = 0; n < 2; ++n) {
                const int col = u.pn * 256 + 128 * bj + 32 * wc + 16 * n + 4 * fq;
#pragma unroll
                for (int ai = 0; ai < 2; ++ai)
#pragma unroll
                    for (int m = 0; m < 4; ++m) {
                        const int row = u.pm * 256 + ai * 128 + wr * 64 + m * 16 + fr;
                        const f32x4 v = acc[ai][bj][m][n];
                        if (u.pn < 4) {
                            *(f32x4*)(out + OMK + (size_t)row * DM + col) = v;
                            u32x2 w; w.x = pk2(v[0], v[1]); w.y = pk2(v[2], v[3]);
                            *(u32x2*)(KB + (size_t)row * DM + col) = w;
                        } else {
                            const int c = col - DM;
                            *(f32x4*)(out + OMV + (size_t)row * DM + c) = v;
                            const int b = row >> 8, key = row & 255, h = c >> 8, d = c & 255;
                            bf16_t* vt = VT + ((size_t)((b * 4 + h) * 256 + d)) * 256 + key;
                            const unsigned w0 = pk2(v[0], v[1]), w1 = pk2(v[2], v[3]);
                            vt[0] = (bf16_t)(w0 & 0xffffu); vt[256] = (bf16_t)(w0 >> 16); vt[512] = (bf16_t)(w1 & 0xffffu); vt[768] = (bf16_t)(w1 >> 16);
                        }
                    }
            }
    }
};
template <int MODE, bool HAS_BF, bool HAS_STATS, bool HAS_BIAS>
struct EpiRes {
    static constexpr bool PERM = false, AFTER_DRAIN = false;
    const float* xp; const float* xs; const float* Rprev; const float* stp; const float* g; const float* b;
    float* Rout; bf16_t* Rb; float* st; const float* bias;
    __device__ __forceinline__ void operator()(const f32x4 (&acc)[2][2][4][2], const Unit& u, int wr, int wc, int fr, int fq) const {
        const int colb = u.pn * 256 + 32 * wc + 4 * fq;
        f32x4 g4[2][2], b4[2][2], bi4[2][2];
#pragma unroll
        for (int bj = 0; bj < 2; ++bj)
#pragma unroll
            for (int n = 0; n < 2; ++n) { const int col = colb + 128 * bj + 16 * n;
                if (MODE == 1) { g4[bj][n] = *(const f32x4*)(g + col); b4[bj][n] = *(const f32x4*)(b + col); }
                if (HAS_BIAS) bi4[bj][n] = *(const f32x4*)(bias + col); }
#pragma unroll
        for (int ai = 0; ai < 2; ++ai)
#pragma unroll
            for (int m = 0; m < 4; ++m) {
                const int row = u.pm * 256 + ai * 128 + wr * 64 + m * 16 + fr;
                float mu = 0.f, rs = 1.f;
                if (MODE == 1) { const f32x2v s2 = *(const f32x2v*)(stp + 2 * row); mu = s2.x * (1.0f / DM); rs = rsqrtf(fmaxf(s2.y * (1.0f / DM) - mu * mu, 0.f) + LN_EPS); }
                const float* xrow = (MODE == 0) ? ((row < NPT) ? xp + (size_t)row * DM : xs + (size_t)(row - NPT) * DM) : Rprev + (size_t)row * DM;
                float sum = 0.f, sq = 0.f;
#pragma unroll
                for (int bj = 0; bj < 2; ++bj)
#pragma unroll
                    for (int n = 0; n < 2; ++n) { const int col = colb + 128 * bj + 16 * n;
                        f32x4 xv = *(const f32x4*)(xrow + col);
                        if (MODE == 1) xv = (xv - mu) * rs * g4[bj][n] + b4[bj][n];
                        f32x4 r = xv * DN_ALPHA + acc[ai][bj][m][n];
                        if (HAS_BIAS) r = r + bi4[bj][n];
                        *(f32x4*)(Rout + (size_t)row * DM + col) = r;
                        if (HAS_BF) { u32x2 w; w.x = pk2(r[0], r[1]); w.y = pk2(r[2], r[3]); *(u32x2*)(Rb + (size_t)row * DM + col) = w; }
                        if (HAS_STATS) { sum += (r[0] + r[1]) + (r[2] + r[3]); sq += (r[0] * r[0] + r[1] * r[1]) + (r[2] * r[2] + r[3] * r[3]); }
                    }
                if (HAS_STATS) {
                    sum += __shfl_xor(sum, 16); sum += __shfl_xor(sum, 32); sq += __shfl_xor(sq, 16); sq += __shfl_xor(sq, 32);
                    if (fq == 0) { atomicAdd(st + 2 * row, sum); atomicAdd(st + 2 * row + 1, sq); }
                }
            }
    }
};
template <int ACT  , bool HAS_BIAS>
struct EpiFold {
    static constexpr bool PERM = true, AFTER_DRAIN = false;
    bf16_t* O; int ldc; const float* stp; const float* c1; const float* c2; const float* bias; float scale;
    __device__ __forceinline__ void operator()(const f32x4 (&acc)[2][2][4][2], const Unit& u, int wr, int wc, int fr, int fq) const {
        const int colb = u.pn * 256 + 32 * wc + 8 * fq;
        f32x4 c1v[2][2], c2v[2][2];
#pragma unroll
        for (int bj = 0; bj < 2; ++bj)
#pragma unroll
            for (int n = 0; n < 2; ++n) { const int col = colb + 128 * bj + 4 * n; c1v[bj][n] = *(const f32x4*)(c1 + col); c2v[bj][n] = *(const f32x4*)(c2 + col);
                if (HAS_BIAS) c2v[bj][n] = c2v[bj][n] + *(const f32x4*)(bias + col); }
#pragma unroll
        for (int ai = 0; ai < 2; ++ai)
#pragma unroll
            for (int m = 0; m < 4; ++m) {
                const int row = u.pm * 256 + ai * 128 + wr * 64 + m * 16 + fr;
                const f32x2v s2 = *(const f32x2v*)(stp + 2 * row); const float mu = s2.x * (1.0f / DM); const float rs = rsqrtf(fmaxf(s2.y * (1.0f / DM) - mu * mu, 0.f) + LN_EPS);
#pragma unroll
                for (int bj = 0; bj < 2; ++bj) {
                    f32x4 v0 = (acc[ai][bj][m][0] - c1v[bj][0] * mu) * rs + c2v[bj][0], v1 = (acc[ai][bj][m][1] - c1v[bj][1] * mu) * rs + c2v[bj][1];
                    if (ACT == 1) {
#pragma unroll
                        for (int e = 0; e < 4; ++e) { const float a = fmaxf(v0[e], 0.f), c = fmaxf(v1[e], 0.f); v0[e] = a * a; v1[e] = c * c; }
                    }
                    v0 = v0 * scale; v1 = v1 * scale;
                    u32x4 w; w.x = pk2(v0[0], v0[1]); w.y = pk2(v0[2], v0[3]); w.z = pk2(v1[0], v1[1]); w.w = pk2(v1[2], v1[3]);
                    *(u32x4*)(O + (size_t)row * ldc + colb + 128 * bj) = w;
                }
            }
    }
};

__device__ __forceinline__ void gn_swish_store(float v0, float v1, f32x2v gg, f32x2v gb, unsigned* dst) {
    float s = v0 + v1;
#pragma unroll
    for (int o = 1; o < 32; o <<= 1) s += __shfl_xor(s, o);
    const float mean = s * (1.0f / 64.0f); const float d0 = v0 - mean, d1 = v1 - mean;
    float q = d0 * d0 + d1 * d1;
#pragma unroll
    for (int o = 1; o < 32; o <<= 1) q += __shfl_xor(q, o);
    const float rstd = rsqrtf(q * (1.0f / 64.0f) + LN_EPS);
    float y0 = d0 * rstd * gg.x + gb.x, y1 = d1 * rstd * gg.y + gb.y;
    y0 = y0 * fsigmoid(y0); y1 = y1 * fsigmoid(y1);
    *dst = pk2(y0, y1);
}
__device__ __forceinline__ void mixer_prompt_run(const Args& p, int run, int c2) {
    const int b = run >> 7, t0 = (run & 127) * 16;
    const unsigned* U32 = (const unsigned*)p.U(); const unsigned* P32 = (const unsigned*)p.P(); unsigned* M32 = (unsigned*)p.MIX();
    const size_t rowb = (size_t)b * SEQ;
    {
        unsigned pin[31];
#pragma unroll
        for (int i = 0; i < 31; ++i) { const int t = t0 - 15 + i; const unsigned v = P32[(rowb + (t >= 0 ? t : 0)) * 256 + c2]; pin[i] = (t >= 0) ? v : 0u; }
        const int w = 2 << (c2 >> 6);
#pragma unroll
        for (int t = 0; t < 16; ++t) { float s0 = 0.f, s1 = 0.f;
#pragma unroll
            for (int i = 0; i < 16; ++i) { const unsigned v = (i < w) ? pin[15 + t - i] : 0u; s0 += bflo(v); s1 += bfhi(v); }
            const float cnt = (float)min(t0 + t + 1, w); const unsigned cur = pin[15 + t];
            M32[(rowb + t0 + t) * 512 + 256 + c2] = pk2(s0 / cnt - bflo(cur), s1 / cnt - bfhi(cur)); }
    }
    asm volatile("" ::: "memory");
    {
        float w0[31], w1[31];
#pragma unroll
        for (int j = 0; j < 31; ++j) { const f32x2v w = *(const f32x2v*)(p.conv_w() + j * 512 + 2 * c2); w0[j] = w.x; w1[j] = w.y; }
        const f32x2v cb = *(const f32x2v*)(p.conv_b() + 2 * c2);
        const f32x2v gg = *(const f32x2v*)(p.gn_g() + 2 * c2), gb = *(const f32x2v*)(p.gn_b() + 2 * c2);
#pragma unroll 1
        for (int hh = 0; hh < 2; ++hh) {
            float a0[8], a1[8];
#pragma unroll
            for (int t = 0; t < 8; ++t) { a0[t] = cb.x; a1[t] = cb.y; }
#pragma unroll
            for (int i = 0; i < 38; ++i) {
                const int ti = t0 + 8 * hh - 30 + i; unsigned v = U32[(rowb + (ti >= 0 ? ti : 0)) * 256 + c2]; v = (ti >= 0) ? v : 0u; const float x0 = bflo(v), x1 = bfhi(v);
#pragma unroll
                for (int t = 0; t < 8; ++t) { const int j = i - t; if (j >= 0 && j <= 30) { a0[t] = fmaf(w0[j], x0, a0[t]); a1[t] = fmaf(w1[j], x1, a1[t]); } }
                if ((i & 7) == 7) asm volatile("" ::: "memory");
            }
#pragma unroll
            for (int t = 0; t < 8; ++t) gn_swish_store(a0[t], a1[t], gg, gb, M32 + (rowb + t0 + 8 * hh + t) * 512 + c2);
            asm volatile("" ::: "memory");
        }
    }
}
__device__ __forceinline__ void mixer_sample_run(const Args& p, int sb, int c2) {
    const unsigned* U32 = (const unsigned*)p.U(); const unsigned* P32 = (const unsigned*)p.P(); unsigned* M32 = (unsigned*)p.MIX();
    const size_t rowb = (size_t)NPT + (size_t)sb * DECS;
    {
        float w0[31], w1[31];
#pragma unroll
        for (int j = 0; j < 31; ++j) { const f32x2v w = *(const f32x2v*)(p.conv_w() + j * 512 + 2 * c2); w0[j] = w.x; w1[j] = w.y; }
        const f32x2v cb = *(const f32x2v*)(p.conv_b() + 2 * c2);
        float a0[4], a1[4];
#pragma unroll
        for (int t = 0; t < 4; ++t) { a0[t] = cb.x; a1[t] = cb.y; }
#pragma unroll
        for (int i = 0; i < 34; ++i) {
            float x0, x1;
            if (i < 30) { const f32x2v v = *(const f32x2v*)(p.state_conv() + ((size_t)sb * 30 + i) * 512 + 2 * c2); x0 = v.x; x1 = v.y; }
            else { const unsigned v = U32[(rowb + (i - 30)) * 256 + c2]; x0 = bflo(v); x1 = bfhi(v); }
#pragma unroll
            for (int t = 0; t < 4; ++t) { const int j = i - t; if (j >= 0 && j <= 30) { a0[t] = fmaf(w0[j], x0, a0[t]); a1[t] = fmaf(w1[j], x1, a1[t]); } }
        }
        const f32x2v gg = *(const f32x2v*)(p.gn_g() + 2 * c2), gb = *(const f32x2v*)(p.gn_b() + 2 * c2);
#pragma unroll
        for (int t = 0; t < 4; ++t) gn_swish_store(a0[t], a1[t], gg, gb, M32 + (rowb + t) * 512 + c2);
    }
    {
        float q0[19], q1[19];
#pragma unroll
        for (int i = 0; i < 15; ++i) { const f32x2v v = *(const f32x2v*)(p.state_pool() + ((size_t)sb * 15 + i) * 512 + 2 * c2); q0[i] = v.x; q1[i] = v.y; }
#pragma unroll
        for (int t = 0; t < 4; ++t) { const unsigned v = P32[(rowb + t) * 256 + c2]; q0[15 + t] = bflo(v); q1[15 + t] = bfhi(v); }
        const int w = 2 << (c2 >> 6); const float cnt = (float)w;
#pragma unroll
        for (int t = 0; t < 4; ++t) { float s0 = 0.f, s1 = 0.f;
#pragma unroll
            for (int i = 0; i < 16; ++i) { if (i < w) { s0 += q0[15 + t - i]; s1 += q1[15 + t - i]; } }
            M32[(rowb + t) * 512 + 256 + c2] = pk2(s0 / cnt - q0[15 + t], s1 / cnt - q1[15 + t]); }
    }
}
__device__ __forceinline__ void p2_mixer(const Args& p, int G, int bid, int tid) {
    const int half = __builtin_amdgcn_readfirstlane(tid >> 8), c2 = tid & 255;
    for (int it = bid; it < 512 + 64; it += G) {
        if (it < 512) mixer_prompt_run(p, 2 * it + half, c2);
        else mixer_sample_run(p, 2 * (it - 512) + half, c2);
    }
}

#define MFMA32(a, b, c) __builtin_amdgcn_mfma_f32_32x32x16_bf16((a), (b), (c), 0, 0, 0)
constexpr int AT_STRIDE = 528;
__device__ __forceinline__ void attn_prompt_unit(const Args& p, LAS unsigned char* lds, int unit, int tid) {
    const int lane = tid & 63, wid = tid >> 6, r = lane & 31, hi = lane >> 5;
    const int b = unit >> 5, h = (unit >> 3) & 3, qb = unit & 7;
    const size_t qrow = (size_t)b * SEQ + qb * 256 + wid * 32 + r;
    bf16x8 qf[8];
    LAS bf16x8* qlds = (LAS bf16x8*)(lds + 17408 + wid * 8192) + lane;
    { const bf16_t* qp = p.Q() + qrow * DM + h * 256 + 8 * hi;
#pragma unroll
      for (int ks = 0; ks < 8; ++ks) qf[ks] = *(const bf16x8*)(qp + ks * 16);
#pragma unroll
      for (int ks = 0; ks < 8; ++ks) qlds[ks * 64] = *(const bf16x8*)(qp + (8 + ks) * 16); }
    const bf16_t* kbase = p.KB() + (size_t)(b * NMEM) * DM + h * 256;
    const bf16_t* vbase = p.VT() + (size_t)((b * 4 + h) * 256) * 256;
    u32x4 stg[2];
    f32x16 st[8];
#pragma unroll
    for (int t = 0; t < 8; ++t)
#pragma unroll
        for (int i = 0; i < 16; ++i) st[t][i] = 0.f;
#define AT_LOADK(kt) do { _Pragma("unroll") for (int i_ = 0; i_ < 2; ++i_) { const int idx_ = tid + 512 * i_; stg[i_] = *(const u32x4*)(kbase + (size_t)((kt) * 32 + (idx_ >> 5)) * DM + (idx_ & 31) * 8); } } while (0)
#define AT_LOADV(dt) do { _Pragma("unroll") for (int i_ = 0; i_ < 2; ++i_) { const int idx_ = tid + 512 * i_; stg[i_] = *(const u32x4*)(vbase + (size_t)((dt) * 32 + (idx_ >> 5)) * 256 + (idx_ & 31) * 8); } } while (0)
#define AT_WRITE() do { _Pragma("unroll") for (int i_ = 0; i_ < 2; ++i_) { const int idx_ = tid + 512 * i_; *(LAS u32x4*)(lds + (idx_ >> 5) * AT_STRIDE + (idx_ & 31) * 16) = stg[i_]; } } while (0)
    AT_LOADK(0);
#pragma unroll
    for (int kt = 0; kt < 8; ++kt) {
        __syncthreads();
        AT_WRITE();
        if (kt < 7) AT_LOADK(kt + 1); else AT_LOADV(0);
        __syncthreads();
        const LAS unsigned char* ap = lds + r * AT_STRIDE + hi * 16;
#pragma unroll
        for (int ks = 0; ks < 8; ++ks) { const bf16x8 a = *(const LAS bf16x8*)(ap + ks * 32); st[kt] = MFMA32(a, qf[ks], st[kt]); }
#pragma unroll
        for (int ks = 0; ks < 8; ++ks) { const bf16x8 a = *(const LAS bf16x8*)(ap + (8 + ks) * 32); const bf16x8 qb8 = qlds[ks * 64]; st[kt] = MFMA32(a, qb8, st[kt]); }
    }
    float mx = -3.0e38f;
#pragma unroll
    for (int t = 0; t < 8; ++t)
#pragma unroll
        for (int i = 0; i < 16; ++i) mx = fmaxf(mx, st[t][i]);
    mx = fmaxf(mx, __shfl_xor(mx, 32));
    float sum = 0.f;
#pragma unroll
    for (int t = 0; t < 8; ++t)
#pragma unroll
        for (int i = 0; i < 16; ++i) { const float e = __expf(st[t][i] - mx); st[t][i] = e; sum += e; }
    sum += __shfl_xor(sum, 32);
    const float inv = 1.0f / sum;
    bf16x8 pf[16];
#pragma unroll
    for (int t = 0; t < 8; ++t)
#pragma unroll
        for (int s = 0; s < 2; ++s) { u32x4 w; w.x = pk2(st[t][8 * s + 0], st[t][8 * s + 1]); w.y = pk2(st[t][8 * s + 2], st[t][8 * s + 3]); w.z = pk2(st[t][8 * s + 4], st[t][8 * s + 5]); w.w = pk2(st[t][8 * s + 6], st[t][8 * s + 7]);
            pf[2 * t + s] = __builtin_bit_cast(bf16x8, w); }
    bf16_t* orow = p.O() + qrow * DM + h * 256;
#pragma unroll
    for (int dt = 0; dt < 8; ++dt) {
        __syncthreads();
        AT_WRITE();
        if (dt < 7) AT_LOADV(dt + 1);
        __syncthreads();
        f32x16 o;
#pragma unroll
        for (int i = 0; i < 16; ++i) o[i] = 0.f;
        const LAS unsigned char* ap = lds + r * AT_STRIDE + hi * 8;
#pragma unroll
        for (int s16 = 0; s16 < 16; ++s16) { const s16x4 lo = *(const LAS s16x4*)(ap + s16 * 32), hh = *(const LAS s16x4*)(ap + s16 * 32 + 16);
            const bf16x8 a = __builtin_shufflevector(lo, hh, 0, 1, 2, 3, 4, 5, 6, 7); o = MFMA32(a, pf[s16], o); }
#pragma unroll
        for (int g4 = 0; g4 < 4; ++g4) { const int d = dt * 32 + 8 * g4 + 4 * hi;
            u32x2 w; w.x = pk2(o[4 * g4 + 0] * inv, o[4 * g4 + 1] * inv); w.y = pk2(o[4 * g4 + 2] * inv, o[4 * g4 + 3] * inv);
            *(u32x2*)(orow + d) = w; }
    }
    __syncthreads();
#undef AT_LOADK
#undef AT_LOADV
#undef AT_WRITE
}
__device__ __forceinline__ void attn_sample_unit(const Args& p, LAS unsigned char* lds, int unit, int tid) {
    const int lane = tid & 63, wid = tid >> 6;
    const int sb = unit >> 2, h = unit & 3;
    LAS float* S = (LAS float*)lds;
    LAS float* RED = (LAS float*)(lds + 4096);
    const size_t row0 = (size_t)NPT + (size_t)sb * DECS;
    f32x4 qv[4];
#pragma unroll
    for (int i = 0; i < 4; ++i) { const u32x2 w = *(const u32x2*)(p.Q() + (row0 + i) * DM + h * 256 + 4 * lane); qv[i] = (f32x4){bflo(w.x), bfhi(w.x), bflo(w.y), bfhi(w.y)}; }
    const float* kp = p.cache_k() + ((size_t)sb * NMEM * 4 + h) * 256 + 4 * lane;
    const float* vp = p.cache_v() + ((size_t)sb * NMEM * 4 + h) * 256 + 4 * lane;
    const int qi = ((lane & 1) << 1) | ((lane >> 1) & 1);
#pragma unroll 1
    for (int kk = 0; kk < 4; ++kk) {
        f32x4 kv[8];
#pragma unroll
        for (int j = 0; j < 8; ++j) kv[j] = *(const f32x4*)(kp + (size_t)(wid * 32 + kk * 8 + j) * DM);
#pragma unroll
        for (int j = 0; j < 8; ++j) {
            float d[4];
#pragma unroll
            for (int i = 0; i < 4; ++i) d[i] = (kv[j][0] * qv[i][0] + kv[j][1] * qv[i][1]) + (kv[j][2] * qv[i][2] + kv[j][3] * qv[i][3]);
            const bool o1 = lane & 1, o2 = lane & 2;
            float k0 = o1 ? d[2] : d[0], k1 = o1 ? d[3] : d[1]; const float s0 = o1 ? d[0] : d[2], s1 = o1 ? d[1] : d[3];
            k0 += __shfl_xor(s0, 1); k1 += __shfl_xor(s1, 1);
            float kq = o2 ? k1 : k0; const float sq = o2 ? k0 : k1;
            kq += __shfl_xor(sq, 2);
            kq += __shfl_xor(kq, 4); kq += __shfl_xor(kq, 8); kq += __shfl_xor(kq, 16); kq += __shfl_xor(kq, 32);
            if (lane < 4) S[(wid * 32 + kk * 8 + j) * 4 + qi] = kq;
        }
    }
    __syncthreads();
    if (wid < 4) {
        float s[4]; float mx = -3.0e38f;
#pragma unroll
        for (int j = 0; j < 4; ++j) { s[j] = S[(lane + 64 * j) * 4 + wid]; mx = fmaxf(mx, s[j]); }
        mx = wave_max(mx); float sum = 0.f;
#pragma unroll
        for (int j = 0; j < 4; ++j) { s[j] = __expf(s[j] - mx); sum += s[j]; }
        sum = wave_sum(sum); const float inv = 1.0f / sum;
#pragma unroll
        for (int j = 0; j < 4; ++j) S[(lane + 64 * j) * 4 + wid] = s[j] * inv;
    }
    __syncthreads();
    f32x4 acc[4];
#pragma unroll
    for (int i = 0; i < 4; ++i) acc[i] = (f32x4){0.f, 0.f, 0.f, 0.f};
#pragma unroll 1
    for (int kk = 0; kk < 4; ++kk) {
        f32x4 vv[8];
#pragma unroll
        for (int j = 0; j < 8; ++j) vv[j] = *(const f32x4*)(vp + (size_t)(wid * 32 + kk * 8 + j) * DM);
#pragma unroll
        for (int j = 0; j < 8; ++j) { const f32x4 pv = *(const LAS f32x4*)(S + (wid * 32 + kk * 8 + j) * 4);
#pragma unroll
            for (int i = 0; i < 4; ++i) acc[i] = acc[i] + vv[j] * pv[i]; }
    }
#pragma unroll
    for (int i = 0; i < 4; ++i) *(LAS f32x4*)(RED + (wid * 4 + i) * 256 + 4 * lane) = acc[i];
    __syncthreads();
    { const int i = tid >> 7, d = (tid & 127) * 2; float o0 = 0.f, o1 = 0.f;
#pragma unroll
      for (int w = 0; w < 8; ++w) { const f32x2v v = *(const LAS f32x2v*)(RED + (w * 4 + i) * 256 + d); o0 += v.x; o1 += v.y; }
      *(unsigned*)(p.O() + (row0 + i) * DM + h * 256 + d) = pk2(o0, o1); }
    __syncthreads();
}
__device__ __forceinline__ void p5_attention(const Args& p, LAS unsigned char* lds, int G, int bid, int tid) {
    const int vcu = (G % 8 == 0) ? (bid % 8) * (G / 8) + bid / 8 : bid;
    if (vcu & 1) { for (int u = vcu; u < DECB * 4; u += G) attn_sample_unit(p, lds, u, tid); }
    for (int u = vcu; u < NBATCH * 4 * 8; u += G) attn_prompt_unit(p, lds, u, tid);
    if (!(vcu & 1)) { for (int u = vcu; u < DECB * 4; u += G) attn_sample_unit(p, lds, u, tid); }
}

__device__ __forceinline__ void p9_ln3(const Args& p, int G, int bid, int tid) {
    const int lane = tid & 63, gw = bid * 8 + (tid >> 6), NGW = G * 8;
    f32x4 g4[4], b4[4];
#pragma unroll
    for (int j = 0; j < 4; ++j) { g4[j] = ((const f32x4*)p.ln3_g())[lane + 64 * j]; b4[j] = ((const f32x4*)p.ln3_b())[lane + 64 * j]; }
    for (int m = gw; m < MT; m += NGW) {
        f32x4* xr = (f32x4*)(p.out() + OY + (size_t)m * DM) + lane;
        f32x4 v[4]; float s = 0.f;
#pragma unroll
        for (int j = 0; j < 4; ++j) { v[j] = xr[64 * j]; s += (v[j].x + v[j].y) + (v[j].z + v[j].w); }
        const float mean = wave_sum(s) * (1.0f / DM); float s2 = 0.f;
#pragma unroll
        for (int j = 0; j < 4; ++j) { v[j] = v[j] - mean; s2 += (v[j].x * v[j].x + v[j].y * v[j].y) + (v[j].z * v[j].z + v[j].w * v[j].w); }
        const float rstd = rsqrtf(wave_sum(s2) * (1.0f / DM) + LN_EPS);
#pragma unroll
        for (int j = 0; j < 4; ++j) xr[64 * j] = v[j] * rstd * g4[j] + b4[j];
    }
}

#define GEMM_PHASE(EpiT, E, A_, B_, M_, N_, K_, c_) do { pg8::Gemm g_{A_, B_, M_, N_, K_}; pg8::StaticOrder S_; S_.init(M_, N_, G, c_); \
        pg8::gemm_phase<EpiT, pg8::StaticOrder, true, true>(lds, g_, S_, E); } while (0)

__global__ void __launch_bounds__(512, 2) fwd_megakernel(Args a) {
    extern __shared__ __attribute__((aligned(16))) unsigned char lds_raw[];
    LAS unsigned char* lds = (LAS unsigned char*)lds_raw;
    cg::grid_group grid = cg::this_grid();
    const int tid = threadIdx.x, bid = blockIdx.x, G = gridDim.x;
    const Args& p = a;
    const int lo = a.ph_lo, hi = a.ph_hi;
#ifndef PH_MASK
#define PH_MASK 0x3ff
#endif
#define IN(k) (((PH_MASK >> (k)) & 1) && lo <= (k) && (k) < hi)
#define SEAM(k) do { if ((k) + 1 < hi) grid.sync(); } while (0)

    if (IN(0)) { p0_prologue(p, lds, G, bid, tid); SEAM(0); }
    if (IN(1)) {
        { EpiIn E{p.b_in(), p.U(), p.P(), p.out()}; GEMM_PHASE(EpiIn, E, p.XB(), p.Win_t(), MT, DIN, DM, bid); }
        { EpiKV E{p.out(), p.KB(), p.VT()}; const int rot = ((MT / 256) * (DIN / 256)) % G; GEMM_PHASE(EpiKV, E, p.MB(), p.Wkv_t(), MEMROWS, 2 * DM, DM, (bid + G - rot) % G); }
        SEAM(1);
    }
    if (IN(2)) { p2_mixer(p, G, bid, tid); SEAM(2); }
    if (IN(3)) { typedef EpiRes<0, true, true, false> EpiT; EpiT E{p.x_prompt(), p.x_sample(), nullptr, nullptr, nullptr, nullptr, p.R1(), p.R1B(), p.ctl() + CF_ST1, nullptr};
        GEMM_PHASE(EpiT, E, p.MIX(), p.Wout_t(), MT, DM, DM, bid); SEAM(3); }
    if (IN(4)) { typedef EpiFold<0, false> EpiT; EpiT E{p.Q(), DM, p.ctl() + CF_ST1, p.ctl() + CF_C1Q, p.ctl() + CF_C2Q, nullptr, 0.0625f};
        GEMM_PHASE(EpiT, E, p.R1B(), p.Wq_t(), MT, DM, DM, bid); SEAM(4); }
    if (IN(5)) { p5_attention(p, lds, G, bid, tid); SEAM(5); }
    if (IN(6)) { typedef EpiRes<1, true, true, false> EpiT; EpiT E{nullptr, nullptr, p.R1(), p.ctl() + CF_ST1, p.ln1_g(), p.ln1_b(), p.R2(), p.R2B(), p.ctl() + CF_ST2, nullptr};
        GEMM_PHASE(EpiT, E, p.O(), p.Wo_t(), MT, DM, DM, bid); SEAM(6); }
    if (IN(7)) { typedef EpiFold<1, true> EpiT; EpiT E{p.H(), DFF, p.ctl() + CF_ST2, p.ctl() + CF_C1H, p.ctl() + CF_C2H, p.b1(), 1.0f};
        GEMM_PHASE(EpiT, E, p.R2B(), p.W1_t(), MT, DFF, DM, bid); SEAM(7); }
    if (IN(8)) { typedef EpiRes<1, false, false, true> EpiT; EpiT E{nullptr, nullptr, p.R2(), p.ctl() + CF_ST2, p.ln2_g(), p.ln2_b(), p.out() + OY, nullptr, nullptr, p.b2()};
        GEMM_PHASE(EpiT, E, p.H(), p.W2_t(), MT, DM, DFF, bid); SEAM(8); }
    if (IN(9)) { p9_ln3(p, G, bid, tid); }
#undef IN
#undef SEAM
}

extern "C" void kernel_launch(void* const* d_in, const int* in_sizes, int n_in, void* d_out, int out_size, void* d_ws, size_t ws_size, hipStream_t stream) {
    static int grid = 0;
    if (grid == 0) {
        if (n_in != 30 || (size_t)out_size != OEND || ws_size < WS_END) { fprintf(stderr, "kernel_launch: unexpected problem shape (n_in %d, out %d, ws %zu)\n", n_in, out_size, ws_size); grid = -1; return; }
        int dev = 0, cus = 0, per_cu = 0;
        if (hipGetDevice(&dev) != hipSuccess || hipDeviceGetAttribute(&cus, hipDeviceAttributeMultiprocessorCount, dev) != hipSuccess) { grid = -1; return; }
        if (hipFuncSetAttribute((const void*)fwd_megakernel, hipFuncAttributeMaxDynamicSharedMemorySize, LDS_BYTES) != hipSuccess) { fprintf(stderr, "kernel_launch: hipFuncSetAttribute failed\n"); grid = -1; return; }
        if (hipOccupancyMaxActiveBlocksPerMultiprocessor(&per_cu, (const void*)fwd_megakernel, 512, LDS_BYTES) != hipSuccess || per_cu < 1) { fprintf(stderr, "kernel_launch: occupancy query failed (%d)\n", per_cu); (void)hipGetLastError(); grid = -1; return; }
        grid = cus * per_cu;
    }
    if (grid < 0) return;
    (void)hipMemsetAsync((char*)d_ws + WS_CTL, 0, CTL_ZERO_BYTES, stream);
    Args a{};
    for (int i = 0; i < 30; ++i) a.in[i] = (const float*)d_in[i];
    a.outp = (float*)d_out; a.ws = (unsigned char*)d_ws;
#if MK_PER_PHASE
    for (int ph = 0; ph < NPHASE; ++ph) { a.ph_lo = ph; a.ph_hi = ph + 1; hipLaunchKernelGGL(fwd_megakernel, dim3(grid), dim3(512), LDS_BYTES, stream, a); }
#else
    a.ph_lo = 0; a.ph_hi = NPHASE;
    void* args[] = {&a};
    hipError_t e = hipLaunchCooperativeKernel((const void*)fwd_megakernel, dim3(grid), dim3(512), args, LDS_BYTES, stream);
    if (e != hipSuccess) fprintf(stderr, "kernel_launch: cooperative launch failed: %s (grid %d)\n", hipGetErrorString(e), grid);
#endif
}
```

```cpp
#include <hip/hip_runtime.h>
#include <hip/hip_cooperative_groups.h>
#include <cstdio>
#include <cstdint>
namespace cg = cooperative_groups;
namespace pg8 {
#define PG8_LAS __attribute__((address_space(3)))
typedef unsigned short bf16_t;
typedef short bf16x8 __attribute__((ext_vector_type(8)));
typedef float f32x4 __attribute__((ext_vector_type(4)));
typedef unsigned u32x4 __attribute__((ext_vector_type(4)));
constexpr int BM = 256, BK = 64, HALF = 128, HTB = HALF * BK * 2  , STAGE_BYTES = 8 * HTB, NXCD = 8, WGM = 8;

__host__ __device__ __forceinline__ int lds_byte(int r, int c) { const int st = (r >> 4) * 2 + (c >> 5), rr = r & 15, cc = c & 31, ob = rr * 64 + cc * 2; return st * 1024 + (ob ^ (((ob >> 9) & 1) << 5)); }
__host__ __device__ __forceinline__ void stage_rc(int b, int& R, int& C) { const int st = b / 1024, sb = b % 1024, swz = sb ^ (((sb >> 9) & 1) << 5); R = (st >> 1) * 16 + swz / 64; C = (st & 1) * 32 + (swz % 64) / 2; }
__host__ __device__ __forceinline__ int perm32(int rho) { const int n = rho >> 4, i = rho & 15; return 8 * (i >> 2) + 4 * n + (i & 3); }

struct Unit { int pm, pn; };
struct Gemm { const bf16_t* A; const bf16_t* Bt; int M, N, K; };

struct StaticOrder {
    int nM, nN, nwg, G, c;
    __host__ __device__ void init(int M, int N, int G_, int c_) { nM = M / BM; nN = N / BM; nwg = nM * nN; G = G_; c = c_; }
    __host__ __device__ bool next(int i, Unit& u) const {
        const long L = (long)i * G + c; if (L >= nwg) return false;
        int wgid = (int)L; { const int q = nwg / NXCD, r = nwg % NXCD, xcd = wgid % NXCD, off = wgid / NXCD; wgid = (xcd < r ? xcd * (q + 1) : r * (q + 1) + (xcd - r) * q) + off; }
        const int nig = WGM * nN, gid = wgid / nig, fm = gid * WGM, gsz = (nM - fm) < WGM ? (nM - fm) : WGM;
        u.pm = fm + ((wgid % nig) % gsz); u.pn = (wgid % nig) / gsz; return true;
    }
    __device__ __forceinline__ void a_ready(const Unit&) const {}
    __device__ __forceinline__ void done(const Unit&) const {}
};

__device__ __forceinline__ unsigned cvt_pk_bf16(float lo, float hi) { unsigned r; asm volatile("v_cvt_pk_bf16_f32 %0, %1, %2" : "=v"(r) : "v"(lo), "v"(hi)); return r; }
typedef float f32x2 __attribute__((ext_vector_type(2)));
template <class Epi, class Sched, bool ALIGN_EPI = false, bool SP2 = false>
__device__ __forceinline__ void gemm_phase(PG8_LAS unsigned char* lds, const Gemm g, const Sched& S, const Epi& E) {
    const int tid = threadIdx.x, wid = __builtin_amdgcn_readfirstlane(tid >> 6), lane = tid & 63, wr = wid >> 2, wc = wid & 3, fr = lane & 15, fq = lane >> 4;
    const int K = g.K, nt = K / BK;
    unsigned voffA[2], voffB[2];
#pragma unroll
    for (int i = 0; i < 2; ++i) { int R, C; stage_rc(tid * 16 + i * 8192, R, C); const int Rb = Epi::PERM ? ((R & ~31) + perm32(R & 31)) : R;
        voffA[i] = (unsigned)(R * K + C) * 2u; voffB[i] = (unsigned)(Rb * K + C) * 2u; }
    const size_t kstep = (size_t)(BK * 2);
    const size_t hstep = (size_t)HALF * K * 2;
    const size_t tstep = 2 * hstep;
    const unsigned ldsw = (unsigned)wid * 1024u;
    const int aoff = lds_byte(wr * 64 + fr, fq * 8), boff = lds_byte(wc * 32 + fr, fq * 8);
#define PG8_SA(b, h) (((b) * 2 + (h)) * HTB)
#define PG8_SB(b, h) ((4 + (b) * 2 + (h)) * HTB)
#define PG8_STAGE(bufoff, gbase, voff) do { _Pragma("unroll") for (int _i = 0; _i < 2; ++_i) \
        __builtin_amdgcn_global_load_lds((const unsigned*)((const char*)(gbase) + (voff)[_i]), (PG8_LAS unsigned*)(lds + (bufoff) + ldsw + _i * 8192), 16, 0, 0); } while (0)
#define PG8_LDA(dst, b, h) do { _Pragma("unroll") for (int m = 0; m < 4; ++m) _Pragma("unroll") for (int k = 0; k < 2; ++k) dst[m][k] = *(const PG8_LAS bf16x8*)(lds + PG8_SA(b, h) + aoff + m * 2048 + k * 1024); } while (0)
#define PG8_LDB(dst, b, h) do { _Pragma("unroll") for (int n = 0; n < 2; ++n) _Pragma("unroll") for (int k = 0; k < 2; ++k) dst[n][k] = *(const PG8_LAS bf16x8*)(lds + PG8_SB(b, h) + boff + n * 2048 + k * 1024); } while (0)
#define PG8_MMA(ai, bj, At, Bt) do { __builtin_amdgcn_s_setprio(1); _Pragma("unroll") for (int m = 0; m < 4; ++m) _Pragma("unroll") for (int n = 0; n < 2; ++n) _Pragma("unroll") for (int k = 0; k < 2; ++k) \
        acc[ai][bj][m][n] = __builtin_amdgcn_mfma_f32_16x16x32_bf16(Bt[n][k], At[m][k], acc[ai][bj][m][n], 0, 0, 0); __builtin_amdgcn_s_setprio(0); } while (0)
#define PG8_WAIT_V(n) asm volatile("s_waitcnt vmcnt(" #n ")" ::: "memory")
#define PG8_WAIT_L(n) asm volatile("s_waitcnt lgkmcnt(" #n ")" ::: "memory")
#define PG8_BAR __builtin_amdgcn_s_barrier()
#define PG8_SCHED __builtin_amdgcn_sched_barrier(0)
    Unit cur, nxt; int ui = 0;
    if (!S.next(0, cur)) return;
    f32x4 acc[2][2][4][2];
#pragma unroll
    for (int a = 0; a < 2; ++a)
#pragma unroll
        for (int b = 0; b < 2; ++b)
#pragma unroll
            for (int m = 0; m < 4; ++m)
#pragma unroll
                for (int n = 0; n < 2; ++n) acc[a][b][m][n] = (f32x4){0.f, 0.f, 0.f, 0.f};
    bf16x8 At[4][2], B0[2][2], B1[2][2];
    const char* cA = (const char*)g.A + (size_t)cur.pm * tstep; const char* cB = (const char*)g.Bt + (size_t)cur.pn * tstep;
    S.a_ready(cur);
    if constexpr (SP2) {
        PG8_STAGE(PG8_SB(0, 0), cB, voffB); PG8_STAGE(PG8_SB(0, 1), cB + hstep, voffB); PG8_STAGE(PG8_SA(0, 0), cA, voffA); PG8_STAGE(PG8_SA(0, 1), cA + hstep, voffA);
        if (wr == 1) PG8_BAR;
        PG8_WAIT_V(2); PG8_BAR;
        PG8_STAGE(PG8_SB(1, 0), cB + kstep, voffB); PG8_STAGE(PG8_SA(1, 0), cA + kstep, voffA); PG8_STAGE(PG8_SB(1, 1), cB + hstep + kstep, voffB);
        PG8_WAIT_V(6); PG8_BAR;
    } else {
        PG8_STAGE(PG8_SB(0, 0), cB, voffB); PG8_STAGE(PG8_SA(0, 0), cA, voffA); PG8_STAGE(PG8_SB(0, 1), cB + hstep, voffB); PG8_STAGE(PG8_SA(0, 1), cA + hstep, voffA);
        if (wr == 1) PG8_BAR;
        PG8_WAIT_V(4); PG8_BAR;
        PG8_STAGE(PG8_SB(1, 0), cB + kstep, voffB); PG8_STAGE(PG8_SA(1, 0), cA + kstep, voffA); PG8_STAGE(PG8_SB(1, 1), cB + hstep + kstep, voffB);
        PG8_WAIT_V(6); PG8_BAR;
    }
    for (;;) {
        const bool has_next = S.next(ui + 1, nxt);
        const char* nA = has_next ? (const char*)g.A + (size_t)nxt.pm * tstep : cA; const char* nB = has_next ? (const char*)g.Bt + (size_t)nxt.pn * tstep : cB;
        for (int t = 0; t < nt; t += 2) {
            const bool last = (t == nt - 2);
            const char* a1 = cA + (size_t)(t + 1) * kstep;
            const char* a2 = last ? nA : cA + (size_t)(t + 2) * kstep; const char* b2 = last ? nB : cB + (size_t)(t + 2) * kstep;
            const char* a3 = a2 + kstep; const char* b3 = b2 + kstep;
            if (last && has_next) S.a_ready(nxt);
            if constexpr (SP2) {
            PG8_LDB(B0, 0, 0); PG8_LDB(B1, 0, 1); PG8_SCHED; PG8_LDA(At, 0, 0); PG8_STAGE(PG8_SA(1, 1), a1 + hstep, voffA);
            PG8_WAIT_V(8); PG8_WAIT_L(0); PG8_BAR; PG8_MMA(0, 0, At, B0); PG8_MMA(0, 1, At, B1); PG8_BAR; PG8_SCHED;
            PG8_LDA(At, 0, 1); PG8_STAGE(PG8_SB(0, 0), b2, voffB); PG8_STAGE(PG8_SB(0, 1), b2 + hstep, voffB); PG8_STAGE(PG8_SA(0, 0), a2, voffA);
            PG8_WAIT_V(8); PG8_WAIT_L(0); PG8_BAR; PG8_MMA(1, 0, At, B0); PG8_MMA(1, 1, At, B1); PG8_BAR; PG8_SCHED;
            PG8_LDB(B0, 1, 0); PG8_LDB(B1, 1, 1); PG8_SCHED; PG8_LDA(At, 1, 0); PG8_STAGE(PG8_SA(0, 1), a2 + hstep, voffA);
            PG8_WAIT_V(8); PG8_WAIT_L(0); PG8_BAR; PG8_MMA(0, 0, At, B0); PG8_MMA(0, 1, At, B1); PG8_BAR; PG8_SCHED;
            PG8_LDA(At, 1, 1); PG8_STAGE(PG8_SB(1, 0), b3, voffB); PG8_STAGE(PG8_SB(1, 1), b3 + hstep, voffB); PG8_STAGE(PG8_SA(1, 0), a3, voffA);
            PG8_WAIT_V(8); PG8_WAIT_L(0); PG8_BAR; PG8_MMA(1, 0, At, B0); PG8_MMA(1, 1, At, B1); PG8_BAR; PG8_SCHED;
            } else {
            PG8_LDB(B0, 0, 0); PG8_SCHED; PG8_LDA(At, 0, 0); PG8_STAGE(PG8_SA(1, 1), a1 + hstep, voffA);
            PG8_WAIT_L(8); PG8_BAR; PG8_WAIT_L(0); PG8_MMA(0, 0, At, B0); PG8_BAR; PG8_SCHED;
            PG8_LDB(B1, 0, 1); PG8_STAGE(PG8_SB(0, 0), b2, voffB);
            PG8_BAR; PG8_WAIT_L(0); PG8_MMA(0, 1, At, B1); PG8_BAR;
            PG8_LDA(At, 0, 1); PG8_STAGE(PG8_SA(0, 0), a2, voffA);
            PG8_BAR; PG8_WAIT_L(0); PG8_MMA(1, 0, At, B0); PG8_BAR; PG8_SCHED;
            PG8_STAGE(PG8_SB(0, 1), b2 + hstep, voffB);
            PG8_WAIT_V(6); PG8_BAR; PG8_MMA(1, 1, At, B1); PG8_BAR;
            PG8_LDB(B0, 1, 0); PG8_SCHED; PG8_LDA(At, 1, 0); PG8_STAGE(PG8_SA(0, 1), a2 + hstep, voffA);
            PG8_WAIT_L(8); PG8_BAR; PG8_WAIT_L(0); PG8_MMA(0, 0, At, B0); PG8_BAR; PG8_SCHED;
            PG8_LDB(B1, 1, 1); PG8_STAGE(PG8_SB(1, 0), b3, voffB);
            PG8_BAR; PG8_WAIT_L(0); PG8_MMA(0, 1, At, B1); PG8_BAR;
            PG8_LDA(At, 1, 1); PG8_STAGE(PG8_SA(1, 0), a3, voffA);
            PG8_BAR; PG8_WAIT_L(0); PG8_MMA(1, 0, At, B0); PG8_BAR; PG8_SCHED;
            PG8_STAGE(PG8_SB(1, 1), b3 + hstep, voffB);
            PG8_WAIT_V(6); PG8_BAR; PG8_MMA(1, 1, At, B1); PG8_BAR;
            }
        }
        if constexpr (ALIGN_EPI) { if (wr == 0) PG8_BAR; }
        if constexpr (!Epi::AFTER_DRAIN) { E(acc, cur, wr, wc, fr, fq); S.done(cur); }
        if (!has_next) break;
#pragma unroll
        for (int a = 0; a < 2; ++a)
#pragma unroll
            for (int b = 0; b < 2; ++b)
#pragma unroll
                for (int m = 0; m < 4; ++m)
#pragma unroll
                    for (int n = 0; n < 2; ++n) acc[a][b][m][n] = (f32x4){0.f, 0.f, 0.f, 0.f};
        cur = nxt; cA = nA; cB = nB; ++ui;
        if constexpr (ALIGN_EPI) { if (wr == 1) PG8_BAR; }
    }
    PG8_WAIT_V(0);
    if constexpr (!ALIGN_EPI) { if (wr == 0) PG8_BAR; }
    PG8_BAR;
    if constexpr (Epi::AFTER_DRAIN) { E.fused(acc, cur, wr, wc, fr, fq, lds, wid, lane); S.done(cur); }
#undef PG8_SA
#undef PG8_SB
#undef PG8_STAGE
#undef PG8_LDA
#undef PG8_LDB
#undef PG8_MMA
#undef PG8_WAIT_V
#undef PG8_WAIT_L
#undef PG8_BAR
#undef PG8_SCHED
}
}

#ifndef MK_PER_PHASE
#define MK_PER_PHASE 0
#endif
#define LAS __attribute__((address_space(3)))
using pg8::bf16_t; using pg8::f32x4; using pg8::u32x4; using pg8::bf16x8; using pg8::Unit;
typedef unsigned u32x2 __attribute__((ext_vector_type(2)));
typedef float f32x2v __attribute__((ext_vector_type(2)));
typedef __bf16 b16x2v __attribute__((ext_vector_type(2)));
typedef float f32x16 __attribute__((ext_vector_type(16)));
typedef short s16x4 __attribute__((ext_vector_type(4)));

constexpr int DM = 1024, SEQ = 2048, NBATCH = 8, NPT = NBATCH * SEQ, DECB = 128, DECS = 4, NST = DECB * DECS, MT = NPT + NST;
constexpr int NMEM = 256, MEMROWS = NBATCH * NMEM, DFF = 4096, DIN = 1536, DC = 512;
constexpr float LN_EPS = 1e-5f, DN_ALPHA = 1.18920711500272f;
constexpr int NPHASE = 10;

constexpr size_t OY = 0, OMK = (size_t)MT * DM, OMV = OMK + (size_t)MEMROWS * DM, OCP = OMV + (size_t)MEMROWS * DM, OCS = OCP + (size_t)NBATCH * 30 * 512,
                 OPP = OCS + (size_t)DECB * 30 * 512, OPS = OPP + (size_t)NBATCH * 15 * 512, OEND = OPS + (size_t)DECB * 15 * 512;
constexpr size_t MiB = 1u << 20;
constexpr size_t WS_CTL = 0, CTL_ZERO_BYTES = 512 * 1024;
constexpr size_t WS_WIN = 2 * MiB, WS_WKV = 5 * MiB, WS_WOUT = 9 * MiB, WS_WQ = 11 * MiB, WS_WO = 13 * MiB, WS_W1 = 15 * MiB, WS_W2 = 23 * MiB;
constexpr size_t WS_KB = 31 * MiB, WS_VT = 35 * MiB, WS_MB = 39 * MiB;
constexpr size_t WS_XB = 44 * MiB, WS_U = 77 * MiB, WS_P = WS_U + (size_t)MT * DC * 2, WS_MIX = 110 * MiB, WS_R1B = 143 * MiB, WS_Q = 176 * MiB, WS_O = 209 * MiB;
constexpr size_t WS_R1 = 242 * MiB, WS_R2 = 308 * MiB, WS_R2B = 374 * MiB, WS_END = 407 * MiB;
constexpr size_t WS_H = 44 * MiB;
static_assert(WS_H + (size_t)MT * DFF * 2 <= WS_Q, "H overlay");
constexpr int CF_ST1 = 0, CF_ST2 = 34816, CF_C1Q = 69632, CF_C2Q = 70656, CF_C1H = 71680, CF_C2H = 75776, CF_END = 79872;
static_assert(CF_END * 4 <= (int)CTL_ZERO_BYTES && MT * 2 <= CF_ST2, "ctl");

constexpr int LDS_BYTES = 131072 + 4096;

__device__ __forceinline__ unsigned pk2(float lo, float hi) { f32x2v v = {lo, hi}; b16x2v b = __builtin_convertvector(v, b16x2v); return __builtin_bit_cast(unsigned, b); }
__device__ __forceinline__ float bflo(unsigned v) { return __uint_as_float(v << 16); }
__device__ __forceinline__ float bfhi(unsigned v) { return __uint_as_float(v & 0xffff0000u); }
__device__ __forceinline__ float wave_sum(float v) {
#pragma unroll
    for (int o = 1; o < 64; o <<= 1) v += __shfl_xor(v, o);
    return v;
}
__device__ __forceinline__ float wave_max(float v) {
#pragma unroll
    for (int o = 1; o < 64; o <<= 1) v = fmaxf(v, __shfl_xor(v, o));
    return v;
}
__device__ __forceinline__ float fsigmoid(float x) { return __builtin_amdgcn_rcpf(1.0f + __expf(-x)); }

struct Args {
    const float* in[30]; float* outp; unsigned char* ws; int ph_lo, ph_hi;
    __device__ __forceinline__ const float* x_prompt() const { return in[0]; }
    __device__ __forceinline__ const float* x_sample() const { return in[1]; }
    __device__ __forceinline__ const float* mem_prompt() const { return in[2]; }
    __device__ __forceinline__ const float* cache_k() const { return in[3]; }
    __device__ __forceinline__ const float* cache_v() const { return in[4]; }
    __device__ __forceinline__ const float* state_conv() const { return in[5]; }
    __device__ __forceinline__ const float* state_pool() const { return in[6]; }
    __device__ __forceinline__ const float* w_in() const { return in[7]; }
    __device__ __forceinline__ const float* b_in() const { return in[8]; }
    __device__ __forceinline__ const float* conv_w() const { return in[9]; }
    __device__ __forceinline__ const float* conv_b() const { return in[10]; }
    __device__ __forceinline__ const float* gn_g() const { return in[11]; }
    __device__ __forceinline__ const float* gn_b() const { return in[12]; }
    __device__ __forceinline__ const float* pool_w() const { return in[13]; }
    __device__ __forceinline__ const float* pool_scale() const { return in[14]; }
    __device__ __forceinline__ const float* w_out() const { return in[15]; }
    __device__ __forceinline__ const float* ln1_g() const { return in[16]; }
    __device__ __forceinline__ const float* ln1_b() const { return in[17]; }
    __device__ __forceinline__ const float* xq_w() const { return in[18]; }
    __device__ __forceinline__ const float* xk_w() const { return in[19]; }
    __device__ __forceinline__ const float* xv_w() const { return in[20]; }
    __device__ __forceinline__ const float* xo_w() const { return in[21]; }
    __device__ __forceinline__ const float* ln2_g() const { return in[22]; }
    __device__ __forceinline__ const float* ln2_b() const { return in[23]; }
    __device__ __forceinline__ const float* w1() const { return in[24]; }
    __device__ __forceinline__ const float* b1() const { return in[25]; }
    __device__ __forceinline__ const float* w2() const { return in[26]; }
    __device__ __forceinline__ const float* b2() const { return in[27]; }
    __device__ __forceinline__ const float* ln3_g() const { return in[28]; }
    __device__ __forceinline__ const float* ln3_b() const { return in[29]; }
    __device__ __forceinline__ float* out() const { return outp; }
    __device__ __forceinline__ float* ctl() const { return (float*)(ws + WS_CTL); }
    __device__ __forceinline__ bf16_t* Win_t() const { return (bf16_t*)(ws + WS_WIN); }
    __device__ __forceinline__ bf16_t* Wkv_t() const { return (bf16_t*)(ws + WS_WKV); }
    __device__ __forceinline__ bf16_t* Wout_t() const { return (bf16_t*)(ws + WS_WOUT); }
    __device__ __forceinline__ bf16_t* Wq_t() const { return (bf16_t*)(ws + WS_WQ); }
    __device__ __forceinline__ bf16_t* Wo_t() const { return (bf16_t*)(ws + WS_WO); }
    __device__ __forceinline__ bf16_t* W1_t() const { return (bf16_t*)(ws + WS_W1); }
    __device__ __forceinline__ bf16_t* W2_t() const { return (bf16_t*)(ws + WS_W2); }
    __device__ __forceinline__ bf16_t* KB() const { return (bf16_t*)(ws + WS_KB); }
    __device__ __forceinline__ bf16_t* VT() const { return (bf16_t*)(ws + WS_VT); }
    __device__ __forceinline__ bf16_t* MB() const { return (bf16_t*)(ws + WS_MB); }
    __device__ __forceinline__ bf16_t* XB() const { return (bf16_t*)(ws + WS_XB); }
    __device__ __forceinline__ bf16_t* U() const { return (bf16_t*)(ws + WS_U); }
    __device__ __forceinline__ bf16_t* P() const { return (bf16_t*)(ws + WS_P); }
    __device__ __forceinline__ bf16_t* MIX() const { return (bf16_t*)(ws + WS_MIX); }
    __device__ __forceinline__ bf16_t* R1B() const { return (bf16_t*)(ws + WS_R1B); }
    __device__ __forceinline__ bf16_t* Q() const { return (bf16_t*)(ws + WS_Q); }
    __device__ __forceinline__ bf16_t* O() const { return (bf16_t*)(ws + WS_O); }
    __device__ __forceinline__ bf16_t* R2B() const { return (bf16_t*)(ws + WS_R2B); }
    __device__ __forceinline__ bf16_t* H() const { return (bf16_t*)(ws + WS_H); }
    __device__ __forceinline__ float* R1() const { return (float*)(ws + WS_R1); }
    __device__ __forceinline__ float* R2() const { return (float*)(ws + WS_R2); }
};

__device__ __forceinline__ int win_dest(int n) {
    if (n < 512) return 32 * (n >> 4) + (n & 15);
    if (n < 1024) { const int c = n - 512; return 32 * (c >> 4) + 16 + (c & 15); }
    return n;
}
template <int MODE>
__device__ __forceinline__ void tr_item(const float* __restrict__ W, int N, bf16_t* WT, int ldk, int row_off, LAS float* scr, int kb, int nb, int lane,
                                        const float* g, const float* b, float* c1, float* c2) {
    const int k0 = 64 * kb, n0 = 32 * nb;
    float tv[32];
#pragma unroll
    for (int i = 0; i < 32; ++i) tv[i] = W[(size_t)(k0 + 2 * i + (lane >> 5)) * N + n0 + (lane & 31)];
#pragma unroll
    for (int i = 0; i < 32; ++i) scr[(2 * i + (lane >> 5)) * 33 + (lane & 31)] = tv[i];
    asm volatile("s_waitcnt lgkmcnt(0)" ::: "memory");
    if (MODE == 2) {
        const float* vec = (lane < 32) ? g : b; float s = 0.f;
#pragma unroll 8
        for (int k = 0; k < 64; ++k) s += vec[k0 + k] * scr[k * 33 + (lane & 31)];
        atomicAdd(((lane < 32) ? c1 : c2) + n0 + (lane & 31), s);
    }
    const int c = lane & 7;
    float gs[8];
#pragma unroll
    for (int i = 0; i < 8; ++i) gs[i] = (MODE == 2) ? g[k0 + 8 * c + i] : 1.0f;
#pragma unroll
    for (int j = 0; j < 4; ++j) { const int n = (lane >> 3) + 8 * j; const LAS float* s = scr + (8 * c) * 33 + n;
        u32x4 o; o.x = pk2(s[0 * 33] * gs[0], s[1 * 33] * gs[1]); o.y = pk2(s[2 * 33] * gs[2], s[3 * 33] * gs[3]); o.z = pk2(s[4 * 33] * gs[4], s[5 * 33] * gs[5]); o.w = pk2(s[6 * 33] * gs[6], s[7 * 33] * gs[7]);
        const int dr = (MODE == 1) ? win_dest(n0 + n) : (n0 + n);
        *(u32x4*)(WT + (size_t)(row_off + dr) * ldk + k0 + 8 * c) = o; }
    asm volatile("s_waitcnt lgkmcnt(0)" ::: "memory");
}
__device__ __forceinline__ void poolfold_block(const Args& p, LAS unsigned char* lds, int item, int tid) {
    const int g = item >> 5, nb = item & 31;
    LAS float* PW = (LAS float*)lds;
    LAS float* WO = (LAS float*)(lds + 128 * 132 * 4);
    const float* pw = p.pool_w() + (size_t)g * 16384;
#pragma unroll
    for (int i = 0; i < 8; ++i) { const int idx = tid + 512 * i; *(LAS f32x4*)(PW + (idx >> 5) * 132 + 4 * (idx & 31)) = ((const f32x4*)pw)[idx]; }
#pragma unroll
    for (int i = 0; i < 8; ++i) { const int idx = tid + 512 * i, d = idx >> 5, n = idx & 31; WO[idx] = p.w_out()[(size_t)(512 + 128 * g + d) * DM + 32 * nb + n] * p.pool_scale()[128 * g + d]; }
    __syncthreads();
    const int n = tid & 31, cg = tid >> 5;
    float acc[8];
#pragma unroll
    for (int j = 0; j < 8; ++j) acc[j] = 0.f;
#pragma unroll 4
    for (int d4 = 0; d4 < 32; ++d4) {
        const float w0 = WO[(4 * d4 + 0) * 32 + n], w1 = WO[(4 * d4 + 1) * 32 + n], w2 = WO[(4 * d4 + 2) * 32 + n], w3 = WO[(4 * d4 + 3) * 32 + n];
#pragma unroll
        for (int j = 0; j < 8; ++j) { const f32x4 q = *(const LAS f32x4*)(PW + (cg * 8 + j) * 132 + 4 * d4); acc[j] = fmaf(q[0], w0, fmaf(q[1], w1, fmaf(q[2], w2, fmaf(q[3], w3, acc[j])))); }
    }
    u32x4 o; o.x = pk2(acc[0], acc[1]); o.y = pk2(acc[2], acc[3]); o.z = pk2(acc[4], acc[5]); o.w = pk2(acc[6], acc[7]);
    *(u32x4*)(p.Wout_t() + (size_t)(32 * nb + n) * DM + 512 + 128 * g + cg * 8) = o;
    __syncthreads();
}
__device__ __forceinline__ void row_to_bf16(const float* xrow, bf16_t* orow, int lane) {
    const f32x4* xr = (const f32x4*)xrow + lane; unsigned long long* o8 = (unsigned long long*)orow + lane;
    f32x4 v[4];
#pragma unroll
    for (int j = 0; j < 4; ++j) v[j] = xr[64 * j];
#pragma unroll
    for (int j = 0; j < 4; ++j) o8[64 * j] = (unsigned long long)pk2(v[j].x, v[j].y) | ((unsigned long long)pk2(v[j].z, v[j].w) << 32);
}
__device__ __forceinline__ void p0_prologue(const Args& p, LAS unsigned char* lds, int G, int bid, int tid) {
    const int lane = tid & 63, wave = tid >> 6;
    LAS float* scr = (LAS float*)(lds + wave * 16384);
    const int gw = bid * 8 + wave, NGW = G * 8;
    constexpr int I_IN = 16 * 48, I_K = 16 * 32, I_V = I_K, I_OUT = 8 * 32, I_Q = I_K, I_O = I_K, I_1 = 16 * 128, I_2 = 64 * 32;
    constexpr int NITEMS = I_IN + I_K + I_V + I_OUT + I_Q + I_O + I_1 + I_2;
    for (int it = bid; it < 128; it += G) poolfold_block(p, lds, it, tid);
    for (int it = gw; it < NITEMS; it += NGW) {
        int r = it;
        if (r < I_IN) { tr_item<1>(p.w_in(), DIN, p.Win_t(), DM, 0, scr, r / 48, r % 48, lane, nullptr, nullptr, nullptr, nullptr); continue; } r -= I_IN;
        if (r < I_K) { tr_item<0>(p.xk_w(), DM, p.Wkv_t(), DM, 0, scr, r / 32, r % 32, lane, nullptr, nullptr, nullptr, nullptr); continue; } r -= I_K;
        if (r < I_V) { tr_item<0>(p.xv_w(), DM, p.Wkv_t(), DM, DM, scr, r / 32, r % 32, lane, nullptr, nullptr, nullptr, nullptr); continue; } r -= I_V;
        if (r < I_OUT) { tr_item<0>(p.w_out(), DM, p.Wout_t(), DM, 0, scr, r / 32, r % 32, lane, nullptr, nullptr, nullptr, nullptr); continue; } r -= I_OUT;
        if (r < I_Q) { tr_item<2>(p.xq_w(), DM, p.Wq_t(), DM, 0, scr, r / 32, r % 32, lane, p.ln1_g(), p.ln1_b(), p.ctl() + CF_C1Q, p.ctl() + CF_C2Q); continue; } r -= I_Q;
        if (r < I_O) { tr_item<0>(p.xo_w(), DM, p.Wo_t(), DM, 0, scr, r / 32, r % 32, lane, nullptr, nullptr, nullptr, nullptr); continue; } r -= I_O;
        if (r < I_1) { tr_item<2>(p.w1(), DFF, p.W1_t(), DM, 0, scr, r / 128, r % 128, lane, p.ln2_g(), p.ln2_b(), p.ctl() + CF_C1H, p.ctl() + CF_C2H); continue; } r -= I_1;
        tr_item<0>(p.w2(), DM, p.W2_t(), DFF, 0, scr, r / 32, r % 32, lane, nullptr, nullptr, nullptr, nullptr);
    }
    const int gt = bid * 512 + tid, NT = G * 512;
#define CVT_REGION(src, dst, n4) do { const f32x4* s4_ = (const f32x4*)(src); unsigned long long* d8_ = (unsigned long long*)(dst); \
        _Pragma("unroll 4") for (int i_ = gt; i_ < (n4); i_ += NT) { const f32x4 v_ = s4_[i_]; d8_[i_] = (unsigned long long)pk2(v_.x, v_.y) | ((unsigned long long)pk2(v_.z, v_.w) << 32); } } while (0)
    CVT_REGION(p.x_prompt(), p.XB(), NPT * (DM / 4));
    CVT_REGION(p.x_sample(), p.XB() + (size_t)NPT * DM, NST * (DM / 4));
    CVT_REGION(p.mem_prompt(), p.MB(), MEMROWS * (DM / 4));
#undef CVT_REGION
    for (int i = gt; i < DECB * 3328; i += NT) { const int sb = i / 3328, o = i % 3328; ((f32x4*)(p.out() + OCS + (size_t)sb * 15360))[o] = ((const f32x4*)(p.state_conv() + (size_t)sb * 15360 + 2048))[o]; }
    for (int i = gt; i < DECB * 1408; i += NT) { const int sb = i / 1408, o = i % 1408; ((f32x4*)(p.out() + OPS + (size_t)sb * 7680))[o] = ((const f32x4*)(p.state_pool() + (size_t)sb * 7680 + 2048))[o]; }
}

struct EpiIn {
    static constexpr bool PERM = false, AFTER_DRAIN = false;
    const float* b_in; bf16_t* U; bf16_t* P; float* out;
    __device__ __forceinline__ void operator()(const f32x4 (&acc)[2][2][4][2], const Unit& u, int wr, int wc, int fr, int fq) const {
        if (u.pn < 4) {
#pragma unroll
            for (int bj = 0; bj < 2; ++bj) {
                const int ch = 16 * (8 * u.pn + 4 * bj + wc) + 4 * fq;
                const f32x4 ba = *(const f32x4*)(b_in + ch), bg = *(const f32x4*)(b_in + 512 + ch);
#pragma unroll
                for (int ai = 0; ai < 2; ++ai)
#pragma unroll
                    for (int m = 0; m < 4; ++m) {
                        const int row = u.pm * 256 + ai * 128 + wr * 64 + m * 16 + fr;
                        const f32x4 av = acc[ai][bj][m][0] + ba, gv = acc[ai][bj][m][1] + bg; f32x4 uv;
#pragma unroll
                        for (int e = 0; e < 4; ++e) uv[e] = av[e] * fsigmoid(gv[e]);
                        u32x2 w; w.x = pk2(uv[0], uv[1]); w.y = pk2(uv[2], uv[3]);
                        *(u32x2*)(U + (size_t)row * DC + ch) = w;
                        if (row < NPT) { const int t = row & (SEQ - 1); if (t >= SEQ - 30) *(f32x4*)(out + OCP + ((size_t)(row >> 11) * 30 + (t - (SEQ - 30))) * 512 + ch) = uv; }
                        else { const int s = row - NPT; *(f32x4*)(out + OCS + ((size_t)(s >> 2) * 30 + 26 + (s & 3)) * 512 + ch) = uv; }
                    }
            }
        } else {
#pragma unroll
            for (int bj = 0; bj < 2; ++bj)
#pragma unroll
                for (int n = 0; n < 2; ++n) {
                    const int pc = 256 * (u.pn - 4) + 128 * bj + 32 * wc + 16 * n + 4 * fq;
                    const f32x4 bp = *(const f32x4*)(b_in + 1024 + pc);
#pragma unroll
                    for (int ai = 0; ai < 2; ++ai)
#pragma unroll
                        for (int m = 0; m < 4; ++m) {
                            const int row = u.pm * 256 + ai * 128 + wr * 64 + m * 16 + fr;
                            const f32x4 pv = acc[ai][bj][m][n] + bp;
                            u32x2 w; w.x = pk2(pv[0], pv[1]); w.y = pk2(pv[2], pv[3]);
                            *(u32x2*)(P + (size_t)row * DC + pc) = w;
                            if (row < NPT) { const int t = row & (SEQ - 1); if (t >= SEQ - 15) *(f32x4*)(out + OPP + ((size_t)(row >> 11) * 15 + (t - (SEQ - 15))) * 512 + pc) = pv; }
                            else { const int s = row - NPT; *(f32x4*)(out + OPS + ((size_t)(s >> 2) * 15 + 11 + (s & 3)) * 512 + pc) = pv; }
                        }
                }
        }
    }
};
struct EpiKV {
    static constexpr bool PERM = false, AFTER_DRAIN = false;
    float* out; bf16_t* KB; bf16_t* VT;
    __device__ __forceinline__ void operator()(const f32x4 (&acc)[2][2][4][2], const Unit& u, int wr, int wc, int fr, int fq) const {
#pragma unroll
        for (int bj = 0; bj < 2; ++bj)
#pragma unroll
            for (int n = 0; n < 2; ++n) {
                const int col = u.pn * 256 + 128 * bj + 32 * wc + 16 * n + 4 * fq;
#pragma unroll
                for (int ai = 0; ai < 2; ++ai)
#pragma unroll
                    for (int m = 0; m < 4; ++m) {
                        const int row = u.pm * 256 + ai * 128 + wr * 64 + m * 16 + fr;
                        const f32x4 v = acc[ai][bj][m][n];
                        if (u.pn < 4) {
                            *(f32x4*)(out + OMK + (size_t)row * DM + col) = v;
                            u32x2 w; w.x = pk2(v[0], v[1]); w.y = pk2(v[2], v[3]);
                            *(u32x2*)(KB + (size_t)row * DM + col) = w;
                        } else {
                            const int c = col - DM;
                            *(f32x4*)(out + OMV + (size_t)row * DM + c) = v;
                            const int b = row >> 8, key = row & 255, h = c >> 8, d = c & 255;
                            bf16_t* vt = VT + ((size_t)((b * 4 + h) * 256 + d)) * 256 + key;
                            const unsigned w0 = pk2(v[0], v[1]), w1 = pk2(v[2], v[3]);
                            vt[0] = (bf16_t)(w0 & 0xffffu); vt[256] = (bf16_t)(w0 >> 16); vt[512] = (bf16_t)(w1 & 0xffffu); vt[768] = (bf16_t)(w1 >> 16);
                        }
                    }
            }
    }
};
template <int MODE, bool HAS_BF, bool HAS_STATS, bool HAS_BIAS>
struct EpiRes {
    static constexpr bool PERM = false, AFTER_DRAIN = false;
    const float* xp; const float* xs; const float* Rprev; const float* stp; const float* g; const float* b;
    float* Rout; bf16_t* Rb; float* st; const float* bias;
    __device__ __forceinline__ void operator()(const f32x4 (&acc)[2][2][4][2], const Unit& u, int wr, int wc, int fr, int fq) const {
        const int colb = u.pn * 256 + 32 * wc + 4 * fq;
        f32x4 g4[2][2], b4[2][2], bi4[2][2];
#pragma unroll
        for (int bj = 0; bj < 2; ++bj)
#pragma unroll
            for (int n = 0; n < 2; ++n) { const int col = colb + 128 * bj + 16 * n;
                if (MODE == 1) { g4[bj][n] = *(const f32x4*)(g + col); b4[bj][n] = *(const f32x4*)(b + col); }
                if (HAS_BIAS) bi4[bj][n] = *(const f32x4*)(bias + col); }
#pragma unroll
        for (int ai = 0; ai < 2; ++ai)
#pragma unroll
            for (int m = 0; m < 4; ++m) {
                const int row = u.pm * 256 + ai * 128 + wr * 64 + m * 16 + fr;
                float mu = 0.f, rs = 1.f;
                if (MODE == 1) { const f32x2v s2 = *(const f32x2v*)(stp + 2 * row); mu = s2.x * (1.0f / DM); rs = rsqrtf(fmaxf(s2.y * (1.0f / DM) - mu * mu, 0.f) + LN_EPS); }
                const float* xrow = (MODE == 0) ? ((row < NPT) ? xp + (size_t)row * DM : xs + (size_t)(row - NPT) * DM) : Rprev + (size_t)row * DM;
                float sum = 0.f, sq = 0.f;
#pragma unroll
                for (int bj = 0; bj < 2; ++bj)
#pragma unroll
                    for (int n = 0; n < 2; ++n) { const int col = colb + 128 * bj + 16 * n;
                        f32x4 xv = *(const f32x4*)(xrow + col);
                        if (MODE == 1) xv = (xv - mu) * rs * g4[bj][n] + b4[bj][n];
                        f32x4 r = xv * DN_ALPHA + acc[ai][bj][m][n];
                        if (HAS_BIAS) r = r + bi4[bj][n];
                        *(f32x4*)(Rout + (size_t)row * DM + col) = r;
                        if (HAS_BF) { u32x2 w; w.x = pk2(r[0], r[1]); w.y = pk2(r[2], r[3]); *(u32x2*)(Rb + (size_t)row * DM + col) = w; }
                        if (HAS_STATS) { sum += (r[0] + r[1]) + (r[2] + r[3]); sq += (r[0] * r[0] + r[1] * r[1]) + (r[2] * r[2] + r[3] * r[3]); }
                    }
                if (HAS_STATS) {
                    sum += __shfl_xor(sum, 16); sum += __shfl_xor(sum, 32); sq += __shfl_xor(sq, 16); sq += __shfl_xor(sq, 32);
                    if (fq == 0) { atomicAdd(st + 2 * row, sum); atomicAdd(st + 2 * row + 1, sq); }
                }
            }
    }
};
template <int ACT  , bool HAS_BIAS>
struct EpiFold {
    static constexpr bool PERM = true, AFTER_DRAIN = false;
    bf16_t* O; int ldc; const float* stp; const float* c1; const float* c2; const float* bias; float scale;
    __device__ __forceinline__ void operator()(const f32x4 (&acc)[2][2][4][2], const Unit& u, int wr, int wc, int fr, int fq) const {
        const int colb = u.pn * 256 + 32 * wc + 8 * fq;
        f32x4 c1v[2][2], c2v[2][2];
#pragma unroll
        for (int bj = 0; bj < 2; ++bj)
#pragma unroll
            for (int n = 0; n < 2; ++n) { const int col = colb + 128 * bj + 4 * n; c1v[bj][n] = *(const f32x4*)(c1 + col); c2v[bj][n] = *(const f32x4*)(c2 + col);
                if (HAS_BIAS) c2v[bj][n] = c2v[bj][n] + *(const f32x4*)(bias + col); }
#pragma unroll
        for (int ai = 0; ai < 2; ++ai)
#pragma unroll
            for (int m = 0; m < 4; ++m) {
                const int row = u.pm * 256 + ai * 128 + wr * 64 + m * 16 + fr;
                const f32x2v s2 = *(const f32x2v*)(stp + 2 * row); const float mu = s2.x * (1.0f / DM); const float rs = rsqrtf(fmaxf(s2.y * (1.0f / DM) - mu * mu, 0.f) + LN_EPS);
#pragma unroll
                for (int bj = 0; bj < 2; ++bj) {
                    f32x4 v0 = (acc[ai][bj][m][0] - c1v[bj][0] * mu) * rs + c2v[bj][0], v1 = (acc[ai][bj][m][1] - c1v[bj][1] * mu) * rs + c2v[bj][1];
                    if (ACT == 1) {
#pragma unroll
                        for (int e = 0; e < 4; ++e) { const float a = fmaxf(v0[e], 0.f), c = fmaxf(v1[e], 0.f); v0[e] = a * a; v1[e] = c * c; }
                    }
                    v0 = v0 * scale; v1 = v1 * scale;
                    u32x4 w; w.x = pk2(v0[0], v0[1]); w.y = pk2(v0[2], v0[3]); w.z = pk2(v1[0], v1[1]); w.w = pk2(v1[2], v1[3]);
                    *(u32x4*)(O + (size_t)row * ldc + colb + 128 * bj) = w;
                }
            }
    }
};

constexpr int SG_STRIDE = 528, SG_BOFF = 64 * SG_STRIDE;
template <class Epi>
__device__ __forceinline__ void small_gemm_phase(LAS unsigned char* lds, const bf16_t* A, const bf16_t* Bt, int K, int ld, int ncol64, const Epi& E, int first, int nblk, int bid, int tid) {
    const int lane = tid & 63, wid = tid >> 6, fr = lane & 15, fq = lane >> 4, mt = wid >> 1, nh = wid & 1;
    const int ub = bid - first; if (ub < 0 || ub >= nblk) return;
    const int nch = K >> 8;
    for (int u = ub; u < 8 * ncol64; u += nblk) {
        const int rt = u & 7, ct = u >> 3;
        const int row0 = NPT + 64 * rt, col0 = 64 * ct;
        u32x4 ra[4], rb[4];
#define SG_LOAD(kc) do { _Pragma("unroll") for (int i_ = 0; i_ < 4; ++i_) { const int idx_ = tid + 512 * i_; \
            ra[i_] = *(const u32x4*)(A + (size_t)(row0 + (idx_ >> 5)) * ld + (kc) * 256 + (idx_ & 31) * 8); rb[i_] = *(const u32x4*)(Bt + (size_t)(col0 + (idx_ >> 5)) * ld + (kc) * 256 + (idx_ & 31) * 8); } } while (0)
        SG_LOAD(0);
        f32x4 acc0 = {0.f, 0.f, 0.f, 0.f}, acc1 = {0.f, 0.f, 0.f, 0.f};
        const LAS unsigned char* apl = lds + (16 * mt + fr) * SG_STRIDE + 16 * fq;
        const LAS unsigned char* bpl = lds + SG_BOFF + (32 * nh + fr) * SG_STRIDE + 16 * fq;
#pragma unroll 1
        for (int kc = 0; kc < nch; ++kc) {
            __syncthreads();
#pragma unroll
            for (int i = 0; i < 4; ++i) { const int idx = tid + 512 * i; *(LAS u32x4*)(lds + (idx >> 5) * SG_STRIDE + (idx & 31) * 16) = ra[i]; *(LAS u32x4*)(lds + SG_BOFF + (idx >> 5) * SG_STRIDE + (idx & 31) * 16) = rb[i]; }
            if (kc + 1 < nch) SG_LOAD(kc + 1);
            __syncthreads();
#pragma unroll
            for (int s8 = 0; s8 < 8; ++s8) {
                const bf16x8 a = *(const LAS bf16x8*)(apl + s8 * 64), b0 = *(const LAS bf16x8*)(bpl + s8 * 64), b1 = *(const LAS bf16x8*)(bpl + 16 * SG_STRIDE + s8 * 64);
                acc0 = __builtin_amdgcn_mfma_f32_16x16x32_bf16(b0, a, acc0, 0, 0, 0);
                acc1 = __builtin_amdgcn_mfma_f32_16x16x32_bf16(b1, a, acc1, 0, 0, 0);
            }
        }
#undef SG_LOAD
        E(row0 + 16 * mt + fr, col0 + 32 * nh, fq, acc0, acc1);
    }
    __syncthreads();
}
struct SmallIn {
    const float* b_in; bf16_t* U; bf16_t* P; float* out;
    __device__ __forceinline__ void operator()(int row, int colb, int fq, f32x4 acc0, f32x4 acc1) const {
        const int s = row - NPT;
        if (colb < 1024) {
            const int ch = 16 * (colb >> 5) + 4 * fq;
            const f32x4 av = acc0 + *(const f32x4*)(b_in + ch), gv = acc1 + *(const f32x4*)(b_in + 512 + ch); f32x4 uv;
#pragma unroll
            for (int e = 0; e < 4; ++e) uv[e] = av[e] * fsigmoid(gv[e]);
            u32x2 w; w.x = pk2(uv[0], uv[1]); w.y = pk2(uv[2], uv[3]);
            *(u32x2*)(U + (size_t)row * DC + ch) = w;
            *(f32x4*)(out + OCS + ((size_t)(s >> 2) * 30 + 26 + (s & 3)) * 512 + ch) = uv;
        } else {
#pragma unroll
            for (int t = 0; t < 2; ++t) { const int pc = colb - 1024 + 16 * t + 4 * fq; const f32x4 pv = (t ? acc1 : acc0) + *(const f32x4*)(b_in + 1024 + pc);
                u32x2 w; w.x = pk2(pv[0], pv[1]); w.y = pk2(pv[2], pv[3]);
                *(u32x2*)(P + (size_t)row * DC + pc) = w;
                *(f32x4*)(out + OPS + ((size_t)(s >> 2) * 15 + 11 + (s & 3)) * 512 + pc) = pv; }
        }
    }
};
template <int MODE, bool HAS_BF, bool HAS_STATS, bool HAS_BIAS>
struct SmallRes {
    const float* xs; const float* Rprev; const float* stp; const float* g; const float* b;
    float* Rout; bf16_t* Rb; float* st; const float* bias;
    __device__ __forceinline__ void operator()(int row, int colb, int fq, f32x4 acc0, f32x4 acc1) const {
        float mu = 0.f, rs = 1.f;
        if (MODE == 1) { const f32x2v s2 = *(const f32x2v*)(stp + 2 * row); mu = s2.x * (1.0f / DM); rs = rsqrtf(fmaxf(s2.y * (1.0f / DM) - mu * mu, 0.f) + LN_EPS); }
        const float* xrow = (MODE == 0) ? xs + (size_t)(row - NPT) * DM : Rprev + (size_t)row * DM;
        float sum = 0.f, sq = 0.f;
#pragma unroll
        for (int t = 0; t < 2; ++t) { const int col = colb + 16 * t + 4 * fq;
            f32x4 xv = *(const f32x4*)(xrow + col);
            if (MODE == 1) xv = (xv - mu) * rs * *(const f32x4*)(g + col) + *(const f32x4*)(b + col);
            f32x4 r = xv * DN_ALPHA + (t ? acc1 : acc0);
            if (HAS_BIAS) r = r + *(const f32x4*)(bias + col);
            *(f32x4*)(Rout + (size_t)row * DM + col) = r;
            if (HAS_BF) { u32x2 w; w.x = pk2(r[0], r[1]); w.y = pk2(r[2], r[3]); *(u32x2*)(Rb + (size_t)row * DM + col) = w; }
            if (HAS_STATS) { sum += (r[0] + r[1]) + (r[2] + r[3]); sq += (r[0] * r[0] + r[1] * r[1]) + (r[2] * r[2] + r[3] * r[3]); } }
        if (HAS_STATS) {
            sum += __shfl_xor(sum, 16); sum += __shfl_xor(sum, 32); sq += __shfl_xor(sq, 16); sq += __shfl_xor(sq, 32);
            if (fq == 0) { atomicAdd(st + 2 * row, sum); atomicAdd(st + 2 * row + 1, sq); }
        }
    }
};
template <int ACT, bool HAS_BIAS>
struct SmallFold {
    bf16_t* O; int ldc; const float* stp; const float* c1; const float* c2; const float* bias; float scale;
    __device__ __forceinline__ void operator()(int row, int colb, int fq, f32x4 acc0, f32x4 acc1) const {
        const f32x2v s2 = *(const f32x2v*)(stp + 2 * row); const float mu = s2.x * (1.0f / DM); const float rs = rsqrtf(fmaxf(s2.y * (1.0f / DM) - mu * mu, 0.f) + LN_EPS);
#pragma unroll
        for (int t = 0; t < 2; ++t) { const int col = colb + 16 * t + 4 * fq;
            f32x4 c2v = *(const f32x4*)(c2 + col); if (HAS_BIAS) c2v = c2v + *(const f32x4*)(bias + col);
            f32x4 v = ((t ? acc1 : acc0) - *(const f32x4*)(c1 + col) * mu) * rs + c2v;
            if (ACT == 1) {
#pragma unroll
                for (int e = 0; e < 4; ++e) { const float a = fmaxf(v[e], 0.f); v[e] = a * a; }
            }
            v = v * scale;
            u32x2 w; w.x = pk2(v[0], v[1]); w.y = pk2(v[2], v[3]);
            *(u32x2*)(O + (size_t)row * ldc + col) = w; }
    }
};

__device__ __forceinline__ void gn_swish_store(float v0, float v1, f32x2v gg, f32x2v gb, unsigned* dst) {
    float s = v0 + v1;
#pragma unroll
    for (int o = 1; o < 32; o <<= 1) s += __shfl_xor(s, o);
    const float mean = s * (1.0f / 64.0f); const float d0 = v0 - mean, d1 = v1 - mean;
    float q = d0 * d0 + d1 * d1;
#pragma unroll
    for (int o = 1; o < 32; o <<= 1) q += __shfl_xor(q, o);
    const float rstd = rsqrtf(q * (1.0f / 64.0f) + LN_EPS);
    float y0 = d0 * rstd * gg.x + gb.x, y1 = d1 * rstd * gg.y + gb.y;
    y0 = y0 * fsigmoid(y0); y1 = y1 * fsigmoid(y1);
    *dst = pk2(y0, y1);
}
__device__ __forceinline__ void mixer_prompt_run(const Args& p, int run, int c2) {
    const int b = run >> 7, t0 = (run & 127) * 16;
    const unsigned* U32 = (const unsigned*)p.U(); const unsigned* P32 = (const unsigned*)p.P(); unsigned* M32 = (unsigned*)p.MIX();
    const size_t rowb = (size_t)b * SEQ;
    {
        unsigned pin[31];
#pragma unroll
        for (int i = 0; i < 31; ++i) { const int t = t0 - 15 + i; const unsigned v = P32[(rowb + (t >= 0 ? t : 0)) * 256 + c2]; pin[i] = (t >= 0) ? v : 0u; }
        const int w = 2 << (c2 >> 6);
#pragma unroll
        for (int t = 0; t < 16; ++t) { float s0 = 0.f, s1 = 0.f;
#pragma unroll
            for (int i = 0; i < 16; ++i) { const unsigned v = (i < w) ? pin[15 + t - i] : 0u; s0 += bflo(v); s1 += bfhi(v); }
            const float cnt = (float)min(t0 + t + 1, w); const unsigned cur = pin[15 + t];
            M32[(rowb + t0 + t) * 512 + 256 + c2] = pk2(s0 / cnt - bflo(cur), s1 / cnt - bfhi(cur)); }
    }
    asm volatile("" ::: "memory");
    {
        float w0[31], w1[31];
#pragma unroll
        for (int j = 0; j < 31; ++j) { const f32x2v w = *(const f32x2v*)(p.conv_w() + j * 512 + 2 * c2); w0[j] = w.x; w1[j] = w.y; }
        const f32x2v cb = *(const f32x2v*)(p.conv_b() + 2 * c2);
        const f32x2v gg = *(const f32x2v*)(p.gn_g() + 2 * c2), gb = *(const f32x2v*)(p.gn_b() + 2 * c2);
#pragma unroll 1
        for (int hh = 0; hh < 2; ++hh) {
            float a0[8], a1[8];
#pragma unroll
            for (int t = 0; t < 8; ++t) { a0[t] = cb.x; a1[t] = cb.y; }
#pragma unroll
            for (int i = 0; i < 38; ++i) {
                const int ti = t0 + 8 * hh - 30 + i; unsigned v = U32[(rowb + (ti >= 0 ? ti : 0)) * 256 + c2]; v = (ti >= 0) ? v : 0u; const float x0 = bflo(v), x1 = bfhi(v);
#pragma unroll
                for (int t = 0; t < 8; ++t) { const int j = i - t; if (j >= 0 && j <= 30) { a0[t] = fmaf(w0[j], x0, a0[t]); a1[t] = fmaf(w1[j], x1, a1[t]); } }
                if ((i & 7) == 7) asm volatile("" ::: "memory");
            }
#pragma unroll
            for (int t = 0; t < 8; ++t) gn_swish_store(a0[t], a1[t], gg, gb, M32 + (rowb + t0 + 8 * hh + t) * 512 + c2);
            asm volatile("" ::: "memory");
        }
    }
}
__device__ __forceinline__ void mixer_sample_run(const Args& p, int sb, int c2) {
    const unsigned* U32 = (const unsigned*)p.U(); const unsigned* P32 = (const unsigned*)p.P(); unsigned* M32 = (unsigned*)p.MIX();
    const size_t rowb = (size_t)NPT + (size_t)sb * DECS;
    {
        float w0[31], w1[31];
#pragma unroll
        for (int j = 0; j < 31; ++j) { const f32x2v w = *(const f32x2v*)(p.conv_w() + j * 512 + 2 * c2); w0[j] = w.x; w1[j] = w.y; }
        const f32x2v cb = *(const f32x2v*)(p.conv_b() + 2 * c2);
        float a0[4], a1[4];
#pragma unroll
        for (int t = 0; t < 4; ++t) { a0[t] = cb.x; a1[t] = cb.y; }
#pragma unroll
        for (int i = 0; i < 34; ++i) {
            float x0, x1;
            if (i < 30) { const f32x2v v = *(const f32x2v*)(p.state_conv() + ((size_t)sb * 30 + i) * 512 + 2 * c2); x0 = v.x; x1 = v.y; }
            else { const unsigned v = U32[(rowb + (i - 30)) * 256 + c2]; x0 = bflo(v); x1 = bfhi(v); }
#pragma unroll
            for (int t = 0; t < 4; ++t) { const int j = i - t; if (j >= 0 && j <= 30) { a0[t] = fmaf(w0[j], x0, a0[t]); a1[t] = fmaf(w1[j], x1, a1[t]); } }
        }
        const f32x2v gg = *(const f32x2v*)(p.gn_g() + 2 * c2), gb = *(const f32x2v*)(p.gn_b() + 2 * c2);
#pragma unroll
        for (int t = 0; t < 4; ++t) gn_swish_store(a0[t], a1[t], gg, gb, M32 + (rowb + t) * 512 + c2);
    }
    {
        float q0[19], q1[19];
#pragma unroll
        for (int i = 0; i < 15; ++i) { const f32x2v v = *(const f32x2v*)(p.state_pool() + ((size_t)sb * 15 + i) * 512 + 2 * c2); q0[i] = v.x; q1[i] = v.y; }
#pragma unroll
        for (int t = 0; t < 4; ++t) { const unsigned v = P32[(rowb + t) * 256 + c2]; q0[15 + t] = bflo(v); q1[15 + t] = bfhi(v); }
        const int w = 2 << (c2 >> 6); const float cnt = (float)w;
#pragma unroll
        for (int t = 0; t < 4; ++t) { float s0 = 0.f, s1 = 0.f;
#pragma unroll
            for (int i = 0; i < 16; ++i) { if (i < w) { s0 += q0[15 + t - i]; s1 += q1[15 + t - i]; } }
            M32[(rowb + t) * 512 + 256 + c2] = pk2(s0 / cnt - q0[15 + t], s1 / cnt - q1[15 + t]); }
    }
}
__device__ __forceinline__ void p2_mixer(const Args& p, int G, int bid, int tid) {
    const int half = __builtin_amdgcn_readfirstlane(tid >> 8), c2 = tid & 255;
    for (int it = bid; it < 512 + 64; it += G) {
        if (it < 512) mixer_prompt_run(p, 2 * it + half, c2);
        else mixer_sample_run(p, 2 * (it - 512) + half, c2);
    }
}

#define MFMA32(a, b, c) __builtin_amdgcn_mfma_f32_32x32x16_bf16((a), (b), (c), 0, 0, 0)
constexpr int AT_STRIDE = 528;
__device__ __forceinline__ void attn_prompt_unit(const Args& p, LAS unsigned char* lds, int unit, int tid) {
    const int lane = tid & 63, wid = tid >> 6, r = lane & 31, hi = lane >> 5;
    const int b = unit >> 5, h = (unit >> 3) & 3, qb = unit & 7;
    const size_t qrow = (size_t)b * SEQ + qb * 256 + wid * 32 + r;
    bf16x8 qf[8];
    LAS bf16x8* qlds = (LAS bf16x8*)(lds + 17408 + wid * 8192) + lane;
    { const bf16_t* qp = p.Q() + qrow * DM + h * 256 + 8 * hi;
#pragma unroll
      for (int ks = 0; ks < 8; ++ks) qf[ks] = *(const bf16x8*)(qp + ks * 16);
#pragma unroll
      for (int ks = 0; ks < 8; ++ks) qlds[ks * 64] = *(const bf16x8*)(qp + (8 + ks) * 16); }
    const bf16_t* kbase = p.KB() + (size_t)(b * NMEM) * DM + h * 256;
    const bf16_t* vbase = p.VT() + (size_t)((b * 4 + h) * 256) * 256;
    u32x4 stg[2];
    f32x16 st[8];
#pragma unroll
    for (int t = 0; t < 8; ++t)
#pragma unroll
        for (int i = 0; i < 16; ++i) st[t][i] = 0.f;
#define AT_LOADK(kt) do { _Pragma("unroll") for (int i_ = 0; i_ < 2; ++i_) { const int idx_ = tid + 512 * i_; stg[i_] = *(const u32x4*)(kbase + (size_t)((kt) * 32 + (idx_ >> 5)) * DM + (idx_ & 31) * 8); } } while (0)
#define AT_LOADV(dt) do { _Pragma("unroll") for (int i_ = 0; i_ < 2; ++i_) { const int idx_ = tid + 512 * i_; stg[i_] = *(const u32x4*)(vbase + (size_t)((dt) * 32 + (idx_ >> 5)) * 256 + (idx_ & 31) * 8); } } while (0)
#define AT_WRITE() do { _Pragma("unroll") for (int i_ = 0; i_ < 2; ++i_) { const int idx_ = tid + 512 * i_; *(LAS u32x4*)(lds + (idx_ >> 5) * AT_STRIDE + (idx_ & 31) * 16) = stg[i_]; } } while (0)
    AT_LOADK(0);
#pragma unroll
    for (int kt = 0; kt < 8; ++kt) {
        __syncthreads();
        AT_WRITE();
        if (kt < 7) AT_LOADK(kt + 1); else AT_LOADV(0);
        __syncthreads();
        const LAS unsigned char* ap = lds + r * AT_STRIDE + hi * 16;
#pragma unroll
        for (int ks = 0; ks < 8; ++ks) { const bf16x8 a = *(const LAS bf16x8*)(ap + ks * 32); st[kt] = MFMA32(a, qf[ks], st[kt]); }
#pragma unroll
        for (int ks = 0; ks < 8; ++ks) { const bf16x8 a = *(const LAS bf16x8*)(ap + (8 + ks) * 32); const bf16x8 qb8 = qlds[ks * 64]; st[kt] = MFMA32(a, qb8, st[kt]); }
    }
    float mx = -3.0e38f;
#pragma unroll
    for (int t = 0; t < 8; ++t)
#pragma unroll
        for (int i = 0; i < 16; ++i) mx = fmaxf(mx, st[t][i]);
    mx = fmaxf(mx, __shfl_xor(mx, 32));
    float sum = 0.f;
#pragma unroll
    for (int t = 0; t < 8; ++t)
#pragma unroll
        for (int i = 0; i < 16; ++i) { const float e = __expf(st[t][i] - mx); st[t][i] = e; sum += e; }
    sum += __shfl_xor(sum, 32);
    const float inv = 1.0f / sum;
    bf16x8 pf[16];
#pragma unroll
    for (int t = 0; t < 8; ++t)
#pragma unroll
        for (int s = 0; s < 2; ++s) { u32x4 w; w.x = pk2(st[t][8 * s + 0], st[t][8 * s + 1]); w.y = pk2(st[t][8 * s + 2], st[t][8 * s + 3]); w.z = pk2(st[t][8 * s + 4], st[t][8 * s + 5]); w.w = pk2(st[t][8 * s + 6], st[t][8 * s + 7]);
            pf[2 * t + s] = __builtin_bit_cast(bf16x8, w); }
    bf16_t* orow = p.O() + qrow * DM + h * 256;
#pragma unroll
    for (int dt = 0; dt < 8; ++dt) {
        __syncthreads();
        AT_WRITE();
        if (dt < 7) AT_LOADV(dt + 1);
        __syncthreads();
        f32x16 o;
#pragma unroll
        for (int i = 0; i < 16; ++i) o[i] = 0.f;
        const LAS unsigned char* ap = lds + r * AT_STRIDE + hi * 8;
#pragma unroll
        for (int s16 = 0; s16 < 16; ++s16) { const s16x4 lo = *(const LAS s16x4*)(ap + s16 * 32), hh = *(const LAS s16x4*)(ap + s16 * 32 + 16);
            const bf16x8 a = __builtin_shufflevector(lo, hh, 0, 1, 2, 3, 4, 5, 6, 7); o = MFMA32(a, pf[s16], o); }
#pragma unroll
        for (int g4 = 0; g4 < 4; ++g4) { const int d = dt * 32 + 8 * g4 + 4 * hi;
            u32x2 w; w.x = pk2(o[4 * g4 + 0] * inv, o[4 * g4 + 1] * inv); w.y = pk2(o[4 * g4 + 2] * inv, o[4 * g4 + 3] * inv);
            *(u32x2*)(orow + d) = w; }
    }
    __syncthreads();
#undef AT_LOADK
#undef AT_LOADV
#undef AT_WRITE
}
__device__ __forceinline__ void attn_sample_unit(const Args& p, LAS unsigned char* lds, int unit, int tid) {
    const int lane = tid & 63, wid = tid >> 6;
    const int sb = unit >> 2, h = unit & 3;
    LAS float* S = (LAS float*)lds;
    LAS float* RED = (LAS float*)(lds + 4096);
    const size_t row0 = (size_t)NPT + (size_t)sb * DECS;
    f32x4 qv[4];
#pragma unroll
    for (int i = 0; i < 4; ++i) { const u32x2 w = *(const u32x2*)(p.Q() + (row0 + i) * DM + h * 256 + 4 * lane); qv[i] = (f32x4){bflo(w.x), bfhi(w.x), bflo(w.y), bfhi(w.y)}; }
    const float* kp = p.cache_k() + ((size_t)sb * NMEM * 4 + h) * 256 + 4 * lane;
    const float* vp = p.cache_v() + ((size_t)sb * NMEM * 4 + h) * 256 + 4 * lane;
    const int qi = ((lane & 1) << 1) | ((lane >> 1) & 1);
#pragma unroll 1
    for (int kk = 0; kk < 4; ++kk) {
        f32x4 kv[8];
#pragma unroll
        for (int j = 0; j < 8; ++j) kv[j] = *(const f32x4*)(kp + (size_t)(wid * 32 + kk * 8 + j) * DM);
#pragma unroll
        for (int j = 0; j < 8; ++j) {
            float d[4];
#pragma unroll
            for (int i = 0; i < 4; ++i) d[i] = (kv[j][0] * qv[i][0] + kv[j][1] * qv[i][1]) + (kv[j][2] * qv[i][2] + kv[j][3] * qv[i][3]);
            const bool o1 = lane & 1, o2 = lane & 2;
            float k0 = o1 ? d[2] : d[0], k1 = o1 ? d[3] : d[1]; const float s0 = o1 ? d[0] : d[2], s1 = o1 ? d[1] : d[3];
            k0 += __shfl_xor(s0, 1); k1 += __shfl_xor(s1, 1);
            float kq = o2 ? k1 : k0; const float sq = o2 ? k0 : k1;
            kq += __shfl_xor(sq, 2);
            kq += __shfl_xor(kq, 4); kq += __shfl_xor(kq, 8); kq += __shfl_xor(kq, 16); kq += __shfl_xor(kq, 32);
            if (lane < 4) S[(wid * 32 + kk * 8 + j) * 4 + qi] = kq;
        }
    }
    __syncthreads();
    if (wid < 4) {
        float s[4]; float mx = -3.0e38f;
#pragma unroll
        for (int j = 0; j < 4; ++j) { s[j] = S[(lane + 64 * j) * 4 + wid]; mx = fmaxf(mx, s[j]); }
        mx = wave_max(mx); float sum = 0.f;
#pragma unroll
        for (int j = 0; j < 4; ++j) { s[j] = __expf(s[j] - mx); sum += s[j]; }
        sum = wave_sum(sum); const float inv = 1.0f / sum;
#pragma unroll
        for (int j = 0; j < 4; ++j) S[(lane + 64 * j) * 4 + wid] = s[j] * inv;
    }
    __syncthreads();
    f32x4 acc[4];
#pragma unroll
    for (int i = 0; i < 4; ++i) acc[i] = (f32x4){0.f, 0.f, 0.f, 0.f};
#pragma unroll 1
    for (int kk = 0; kk < 4; ++kk) {
        f32x4 vv[8];
#pragma unroll
        for (int j = 0; j < 8; ++j) vv[j] = *(const f32x4*)(vp + (size_t)(wid * 32 + kk * 8 + j) * DM);
#pragma unroll
        for (int j = 0; j < 8; ++j) { const f32x4 pv = *(const LAS f32x4*)(S + (wid * 32 + kk * 8 + j) * 4);
#pragma unroll
            for (int i = 0; i < 4; ++i) acc[i] = acc[i] + vv[j] * pv[i]; }
    }
#pragma unroll
    for (int i = 0; i < 4; ++i) *(LAS f32x4*)(RED + (wid * 4 + i) * 256 + 4 * lane) = acc[i];
    __syncthreads();
    { const int i = tid >> 7, d = (tid & 127) * 2; float o0 = 0.f, o1 = 0.f;
#pragma unroll
      for (int w = 0; w < 8; ++w) { const f32x2v v = *(const LAS f32x2v*)(RED + (w * 4 + i) * 256 + d); o0 += v.x; o1 += v.y; }
      *(unsigned*)(p.O() + (row0 + i) * DM + h * 256 + d) = pk2(o0, o1); }
    __syncthreads();
}
__device__ __forceinline__ void p5_attention(const Args& p, LAS unsigned char* lds, int G, int bid, int tid) {
    const int vcu = (G % 8 == 0) ? (bid % 8) * (G / 8) + bid / 8 : bid;
    if (vcu & 1) { for (int u = vcu; u < DECB * 4; u += G) attn_sample_unit(p, lds, u, tid); }
    for (int u = vcu; u < NBATCH * 4 * 8; u += G) attn_prompt_unit(p, lds, u, tid);
    if (!(vcu & 1)) { for (int u = vcu; u < DECB * 4; u += G) attn_sample_unit(p, lds, u, tid); }
}

__device__ __forceinline__ void p9_ln3(const Args& p, int G, int bid, int tid) {
    const int lane = tid & 63, gw = bid * 8 + (tid >> 6), NGW = G * 8;
    f32x4 g4[4], b4[4];
#pragma unroll
    for (int j = 0; j < 4; ++j) { g4[j] = ((const f32x4*)p.ln3_g())[lane + 64 * j]; b4[j] = ((const f32x4*)p.ln3_b())[lane + 64 * j]; }
    for (int m = gw; m < MT; m += NGW) {
        f32x4* xr = (f32x4*)(p.out() + OY + (size_t)m * DM) + lane;
        f32x4 v[4]; float s = 0.f;
#pragma unroll
        for (int j = 0; j < 4; ++j) { v[j] = xr[64 * j]; s += (v[j].x + v[j].y) + (v[j].z + v[j].w); }
        const float mean = wave_sum(s) * (1.0f / DM); float s2 = 0.f;
#pragma unroll
        for (int j = 0; j < 4; ++j) { v[j] = v[j] - mean; s2 += (v[j].x * v[j].x + v[j].y * v[j].y) + (v[j].z * v[j].z + v[j].w * v[j].w); }
        const float rstd = rsqrtf(wave_sum(s2) * (1.0f / DM) + LN_EPS);
#pragma unroll
        for (int j = 0; j < 4; ++j) xr[64 * j] = v[j] * rstd * g4[j] + b4[j];
    }
}

#define GEMM_PHASE(EpiT, E, A_, B_, M_, N_, K_, c_) do { pg8::Gemm g_{A_, B_, M_, N_, K_}; pg8::StaticOrder S_; S_.init(M_, N_, G, c_); \
        pg8::gemm_phase<EpiT, pg8::StaticOrder, true, true>(lds, g_, S_, E); } while (0)

__global__ void __launch_bounds__(512, 2) fwd_megakernel(Args a) {
    extern __shared__ __attribute__((aligned(16))) unsigned char lds_raw[];
    LAS unsigned char* lds = (LAS unsigned char*)lds_raw;
    cg::grid_group grid = cg::this_grid();
    const int tid = threadIdx.x, bid = blockIdx.x, G = gridDim.x;
    const Args& p = a;
    const int lo = a.ph_lo, hi = a.ph_hi;
#ifndef PH_MASK
#define PH_MASK 0x3ff
#endif
#define IN(k) (((PH_MASK >> (k)) & 1) && lo <= (k) && (k) < hi)
#define SEAM(k) do { if ((k) + 1 < hi) grid.sync(); } while (0)

    if (IN(0)) { p0_prologue(p, lds, G, bid, tid); SEAM(0); }
    if (IN(1)) {
        { EpiIn E{p.b_in(), p.U(), p.P(), p.out()}; GEMM_PHASE(EpiIn, E, p.XB(), p.Win_t(), NPT, DIN, DM, bid); }
        { EpiKV E{p.out(), p.KB(), p.VT()}; const int rot = ((NPT / 256) * (DIN / 256)) % G; GEMM_PHASE(EpiKV, E, p.MB(), p.Wkv_t(), MEMROWS, 2 * DM, DM, (bid + G - rot) % G); }
        { SmallIn E{p.b_in(), p.U(), p.P(), p.out()}; small_gemm_phase(lds, p.XB(), p.Win_t(), DM, DM, DIN / 64, E, G - G / 4, G / 4, bid, tid); }
        SEAM(1);
    }
    if (IN(2)) { p2_mixer(p, G, bid, tid); SEAM(2); }
    if (IN(3)) { { typedef EpiRes<0, true, true, false> EpiT; EpiT E{p.x_prompt(), p.x_sample(), nullptr, nullptr, nullptr, nullptr, p.R1(), p.R1B(), p.ctl() + CF_ST1, nullptr};
          GEMM_PHASE(EpiT, E, p.MIX(), p.Wout_t(), NPT, DM, DM, bid); }
        { SmallRes<0, true, true, false> E{p.x_sample(), nullptr, nullptr, nullptr, nullptr, p.R1(), p.R1B(), p.ctl() + CF_ST1, nullptr}; small_gemm_phase(lds, p.MIX(), p.Wout_t(), DM, DM, DM / 64, E, 0, G, bid, tid); }
        SEAM(3); }
    if (IN(4)) { { typedef EpiFold<0, false> EpiT; EpiT E{p.Q(), DM, p.ctl() + CF_ST1, p.ctl() + CF_C1Q, p.ctl() + CF_C2Q, nullptr, 0.0625f};
          GEMM_PHASE(EpiT, E, p.R1B(), p.Wq_t(), NPT, DM, DM, bid); }
        { SmallFold<0, false> E{p.Q(), DM, p.ctl() + CF_ST1, p.ctl() + CF_C1Q, p.ctl() + CF_C2Q, nullptr, 0.0625f}; small_gemm_phase(lds, p.R1B(), p.Wq_t(), DM, DM, DM / 64, E, 0, G, bid, tid); }
        SEAM(4); }
    if (IN(5)) { p5_attention(p, lds, G, bid, tid); SEAM(5); }
    if (IN(6)) { { typedef EpiRes<1, true, true, false> EpiT; EpiT E{nullptr, nullptr, p.R1(), p.ctl() + CF_ST1, p.ln1_g(), p.ln1_b(), p.R2(), p.R2B(), p.ctl() + CF_ST2, nullptr};
          GEMM_PHASE(EpiT, E, p.O(), p.Wo_t(), NPT, DM, DM, bid); }
        { SmallRes<1, true, true, false> E{nullptr, p.R1(), p.ctl() + CF_ST1, p.ln1_g(), p.ln1_b(), p.R2(), p.R2B(), p.ctl() + CF_ST2, nullptr}; small_gemm_phase(lds, p.O(), p.Wo_t(), DM, DM, DM / 64, E, 0, G, bid, tid); }
        SEAM(6); }
    if (IN(7)) { { typedef EpiFold<1, true> EpiT; EpiT E{p.H(), DFF, p.ctl() + CF_ST2, p.ctl() + CF_C1H, p.ctl() + CF_C2H, p.b1(), 1.0f};
          GEMM_PHASE(EpiT, E, p.R2B(), p.W1_t(), NPT, DFF, DM, bid); }
        { SmallFold<1, true> E{p.H(), DFF, p.ctl() + CF_ST2, p.ctl() + CF_C1H, p.ctl() + CF_C2H, p.b1(), 1.0f}; small_gemm_phase(lds, p.R2B(), p.W1_t(), DM, DM, DFF / 64, E, 0, G, bid, tid); }
        SEAM(7); }
    if (IN(8)) { { typedef EpiRes<1, false, false, true> EpiT; EpiT E{nullptr, nullptr, p.R2(), p.ctl() + CF_ST2, p.ln2_g(), p.ln2_b(), p.out() + OY, nullptr, nullptr, p.b2()};
          GEMM_PHASE(EpiT, E, p.H(), p.W2_t(), NPT, DM, DFF, bid); }
        { SmallRes<1, false, false, true> E{nullptr, p.R2(), p.ctl() + CF_ST2, p.ln2_g(), p.ln2_b(), p.out() + OY, nullptr, nullptr, p.b2()}; small_gemm_phase(lds, p.H(), p.W2_t(), DFF, DFF, DM / 64, E, 0, G, bid, tid); }
        SEAM(8); }
    if (IN(9)) { p9_ln3(p, G, bid, tid); }
#undef IN
#undef SEAM
}

extern "C" void kernel_launch(void* const* d_in, const int* in_sizes, int n_in, void* d_out, int out_size, void* d_ws, size_t ws_size, hipStream_t stream) {
    static int grid = 0;
    if (grid == 0) {
        if (n_in != 30 || (size_t)out_size != OEND || ws_size < WS_END) { fprintf(stderr, "kernel_launch: unexpected problem shape (n_in %d, out %d, ws %zu)\n", n_in, out_size, ws_size); grid = -1; return; }
        int dev = 0, cus = 0, per_cu = 0;
        if (hipGetDevice(&dev) != hipSuccess || hipDeviceGetAttribute(&cus, hipDeviceAttributeMultiprocessorCount, dev) != hipSuccess) { grid = -1; return; }
        if (hipFuncSetAttribute((const void*)fwd_megakernel, hipFuncAttributeMaxDynamicSharedMemorySize, LDS_BYTES) != hipSuccess) { fprintf(stderr, "kernel_launch: hipFuncSetAttribute failed\n"); grid = -1; return; }
        if (hipOccupancyMaxActiveBlocksPerMultiprocessor(&per_cu, (const void*)fwd_megakernel, 512, LDS_BYTES) != hipSuccess || per_cu < 1) { fprintf(stderr, "kernel_launch: occupancy query failed (%d)\n", per_cu); (void)hipGetLastError(); grid = -1; return; }
        grid = cus * per_cu;
    }
    if (grid < 0) return;
    (void)hipMemsetAsync((char*)d_ws + WS_CTL, 0, CTL_ZERO_BYTES, stream);
    Args a{};
    for (int i = 0; i < 30; ++i) a.in[i] = (const float*)d_in[i];
    a.outp = (float*)d_out; a.ws = (unsigned char*)d_ws;
#if MK_PER_PHASE
#ifndef EXTRA_MASK
#define EXTRA_MASK 0
#endif
    for (int ph = 0; ph < NPHASE; ++ph) { a.ph_lo = ph; a.ph_hi = ph + 1; hipLaunchKernelGGL(fwd_megakernel, dim3(grid), dim3(512), LDS_BYTES, stream, a);
        if ((EXTRA_MASK >> ph) & 1) hipLaunchKernelGGL(fwd_megakernel, dim3(grid), dim3(512), LDS_BYTES, stream, a); }
#else
    a.ph_lo = 0; a.ph_hi = NPHASE;
    void* args[] = {&a};
    hipError_t e = hipLaunchCooperativeKernel((const void*)fwd_megakernel, dim3(grid), dim3(512), args, LDS_BYTES, stream);
    if (e != hipSuccess) fprintf(stderr, "kernel_launch: cooperative launch failed: %s (grid %d)\n", hipGetErrorString(e), grid);
#endif
}
```

```cpp
#include <hip/hip_runtime.h>
#include <hip/hip_cooperative_groups.h>
#include <cstdio>
#include <cstdint>
namespace cg = cooperative_groups;
namespace pg8 {
#define PG8_LAS __attribute__((address_space(3)))
typedef unsigned short bf16_t;
typedef short bf16x8 __attribute__((ext_vector_type(8)));
typedef float f32x4 __attribute__((ext_vector_type(4)));
typedef unsigned u32x4 __attribute__((ext_vector_type(4)));
constexpr int BM = 256, BK = 64, HALF = 128, HTB = HALF * BK * 2  , STAGE_BYTES = 8 * HTB, NXCD = 8, WGM = 8;

__host__ __device__ __forceinline__ int lds_byte(int r, int c) { const int st = (r >> 4) * 2 + (c >> 5), rr = r & 15, cc = c & 31, ob = rr * 64 + cc * 2; return st * 1024 + (ob ^ (((ob >> 9) & 1) << 5)); }
__host__ __device__ __forceinline__ void stage_rc(int b, int& R, int& C) { const int st = b / 1024, sb = b % 1024, swz = sb ^ (((sb >> 9) & 1) << 5); R = (st >> 1) * 16 + swz / 64; C = (st & 1) * 32 + (swz % 64) / 2; }
__host__ __device__ __forceinline__ int perm32(int rho) { const int n = rho >> 4, i = rho & 15; return 8 * (i >> 2) + 4 * n + (i & 3); }

struct Unit { int pm, pn; };
struct Gemm { const bf16_t* A; const bf16_t* Bt; int M, N, K; };

struct StaticOrder {
    int nM, nN, nwg, G, c;
    __host__ __device__ void init(int M, int N, int G_, int c_) { nM = M / BM; nN = N / BM; nwg = nM * nN; G = G_; c = c_; }
    __host__ __device__ bool next(int i, Unit& u) const {
        const long L = (long)i * G + c; if (L >= nwg) return false;
        int wgid = (int)L; { const int q = nwg / NXCD, r = nwg % NXCD, xcd = wgid % NXCD, off = wgid / NXCD; wgid = (xcd < r ? xcd * (q + 1) : r * (q + 1) + (xcd - r) * q) + off; }
        const int nig = WGM * nN, gid = wgid / nig, fm = gid * WGM, gsz = (nM - fm) < WGM ? (nM - fm) : WGM;
        u.pm = fm + ((wgid % nig) % gsz); u.pn = (wgid % nig) / gsz; return true;
    }
    __device__ __forceinline__ void a_ready(const Unit&) const {}
    __device__ __forceinline__ void done(const Unit&) const {}
};

__device__ __forceinline__ unsigned cvt_pk_bf16(float lo, float hi) { unsigned r; asm volatile("v_cvt_pk_bf16_f32 %0, %1, %2" : "=v"(r) : "v"(lo), "v"(hi)); return r; }
typedef float f32x2 __attribute__((ext_vector_type(2)));
template <class Epi, class Sched, bool ALIGN_EPI = false, bool SP2 = false>
__device__ __forceinline__ void gemm_phase(PG8_LAS unsigned char* lds, const Gemm g, const Sched& S, const Epi& E) {
    const int tid = threadIdx.x, wid = __builtin_amdgcn_readfirstlane(tid >> 6), lane = tid & 63, wr = wid >> 2, wc = wid & 3, fr = lane & 15, fq = lane >> 4;
    const int K = g.K, nt = K / BK;
    unsigned voffA[2], voffB[2];
#pragma unroll
    for (int i = 0; i < 2; ++i) { int R, C; stage_rc(tid * 16 + i * 8192, R, C); const int Rb = Epi::PERM ? ((R & ~31) + perm32(R & 31)) : R;
        voffA[i] = (unsigned)(R * K + C) * 2u; voffB[i] = (unsigned)(Rb * K + C) * 2u; }
    const size_t kstep = (size_t)(BK * 2);
    const size_t hstep = (size_t)HALF * K * 2;
    const size_t tstep = 2 * hstep;
    const unsigned ldsw = (unsigned)wid * 1024u;
    const int aoff = lds_byte(wr * 64 + fr, fq * 8), boff = lds_byte(wc * 32 + fr, fq * 8);
#define PG8_SA(b, h) (((b) * 2 + (h)) * HTB)
#define PG8_SB(b, h) ((4 + (b) * 2 + (h)) * HTB)
#define PG8_STAGE(bufoff, gbase, voff) do { _Pragma("unroll") for (int _i = 0; _i < 2; ++_i) \
        __builtin_amdgcn_global_load_lds((const unsigned*)((const char*)(gbase) + (voff)[_i]), (PG8_LAS unsigned*)(lds + (bufoff) + ldsw + _i * 8192), 16, 0, 0); } while (0)
#define PG8_LDA(dst, b, h) do { _Pragma("unroll") for (int m = 0; m < 4; ++m) _Pragma("unroll") for (int k = 0; k < 2; ++k) dst[m][k] = *(const PG8_LAS bf16x8*)(lds + PG8_SA(b, h) + aoff + m * 2048 + k * 1024); } while (0)
#define PG8_LDB(dst, b, h) do { _Pragma("unroll") for (int n = 0; n < 2; ++n) _Pragma("unroll") for (int k = 0; k < 2; ++k) dst[n][k] = *(const PG8_LAS bf16x8*)(lds + PG8_SB(b, h) + boff + n * 2048 + k * 1024); } while (0)
#define PG8_MMA(ai, bj, At, Bt) do { __builtin_amdgcn_s_setprio(1); _Pragma("unroll") for (int m = 0; m < 4; ++m) _Pragma("unroll") for (int n = 0; n < 2; ++n) _Pragma("unroll") for (int k = 0; k < 2; ++k) \
        acc[ai][bj][m][n] = __builtin_amdgcn_mfma_f32_16x16x32_bf16(Bt[n][k], At[m][k], acc[ai][bj][m][n], 0, 0, 0); __builtin_amdgcn_s_setprio(0); } while (0)
#define PG8_WAIT_V(n) asm volatile("s_waitcnt vmcnt(" #n ")" ::: "memory")
#define PG8_WAIT_L(n) asm volatile("s_waitcnt lgkmcnt(" #n ")" ::: "memory")
#define PG8_BAR __builtin_amdgcn_s_barrier()
#define PG8_SCHED __builtin_amdgcn_sched_barrier(0)
    Unit cur, nxt; int ui = 0;
    if (!S.next(0, cur)) return;
    f32x4 acc[2][2][4][2];
#pragma unroll
    for (int a = 0; a < 2; ++a)
#pragma unroll
        for (int b = 0; b < 2; ++b)
#pragma unroll
            for (int m = 0; m < 4; ++m)
#pragma unroll
                for (int n = 0; n < 2; ++n) acc[a][b][m][n] = (f32x4){0.f, 0.f, 0.f, 0.f};
    bf16x8 At[4][2], B0[2][2], B1[2][2];
    const char* cA = (const char*)g.A + (size_t)cur.pm * tstep; const char* cB = (const char*)g.Bt + (size_t)cur.pn * tstep;
    S.a_ready(cur);
    if constexpr (SP2) {
        PG8_STAGE(PG8_SB(0, 0), cB, voffB); PG8_STAGE(PG8_SB(0, 1), cB + hstep, voffB); PG8_STAGE(PG8_SA(0, 0), cA, voffA); PG8_STAGE(PG8_SA(0, 1), cA + hstep, voffA);
        if (wr == 1) PG8_BAR;
        PG8_WAIT_V(2); PG8_BAR;
        PG8_STAGE(PG8_SB(1, 0), cB + kstep, voffB); PG8_STAGE(PG8_SA(1, 0), cA + kstep, voffA); PG8_STAGE(PG8_SB(1, 1), cB + hstep + kstep, voffB);
        PG8_WAIT_V(6); PG8_BAR;
    } else {
        PG8_STAGE(PG8_SB(0, 0), cB, voffB); PG8_STAGE(PG8_SA(0, 0), cA, voffA); PG8_STAGE(PG8_SB(0, 1), cB + hstep, voffB); PG8_STAGE(PG8_SA(0, 1), cA + hstep, voffA);
        if (wr == 1) PG8_BAR;
        PG8_WAIT_V(4); PG8_BAR;
        PG8_STAGE(PG8_SB(1, 0), cB + kstep, voffB); PG8_STAGE(PG8_SA(1, 0), cA + kstep, voffA); PG8_STAGE(PG8_SB(1, 1), cB + hstep + kstep, voffB);
        PG8_WAIT_V(6); PG8_BAR;
    }
    for (;;) {
        const bool has_next = S.next(ui + 1, nxt);
        const char* nA = has_next ? (const char*)g.A + (size_t)nxt.pm * tstep : cA; const char* nB = has_next ? (const char*)g.Bt + (size_t)nxt.pn * tstep : cB;
        for (int t = 0; t < nt; t += 2) {
            const bool last = (t == nt - 2);
            const char* a1 = cA + (size_t)(t + 1) * kstep;
            const char* a2 = last ? nA : cA + (size_t)(t + 2) * kstep; const char* b2 = last ? nB : cB + (size_t)(t + 2) * kstep;
            const char* a3 = a2 + kstep; const char* b3 = b2 + kstep;
            if (last && has_next) S.a_ready(nxt);
            if constexpr (SP2) {
            PG8_LDB(B0, 0, 0); PG8_LDB(B1, 0, 1); PG8_SCHED; PG8_LDA(At, 0, 0); PG8_STAGE(PG8_SA(1, 1), a1 + hstep, voffA);
            PG8_WAIT_V(8); PG8_WAIT_L(0); PG8_BAR; PG8_MMA(0, 0, At, B0); PG8_MMA(0, 1, At, B1); PG8_BAR; PG8_SCHED;
            PG8_LDA(At, 0, 1); PG8_STAGE(PG8_SB(0, 0), b2, voffB); PG8_STAGE(PG8_SB(0, 1), b2 + hstep, voffB); PG8_STAGE(PG8_SA(0, 0), a2, voffA);
            PG8_WAIT_V(8); PG8_WAIT_L(0); PG8_BAR; PG8_MMA(1, 0, At, B0); PG8_MMA(1, 1, At, B1); PG8_BAR; PG8_SCHED;
            PG8_LDB(B0, 1, 0); PG8_LDB(B1, 1, 1); PG8_SCHED; PG8_LDA(At, 1, 0); PG8_STAGE(PG8_SA(0, 1), a2 + hstep, voffA);
            PG8_WAIT_V(8); PG8_WAIT_L(0); PG8_BAR; PG8_MMA(0, 0, At, B0); PG8_MMA(0, 1, At, B1); PG8_BAR; PG8_SCHED;
            PG8_LDA(At, 1, 1); PG8_STAGE(PG8_SB(1, 0), b3, voffB); PG8_STAGE(PG8_SB(1, 1), b3 + hstep, voffB); PG8_STAGE(PG8_SA(1, 0), a3, voffA);
            PG8_WAIT_V(8); PG8_WAIT_L(0); PG8_BAR; PG8_MMA(1, 0, At, B0); PG8_MMA(1, 1, At, B1); PG8_BAR; PG8_SCHED;
            } else {
            PG8_LDB(B0, 0, 0); PG8_SCHED; PG8_LDA(At, 0, 0); PG8_STAGE(PG8_SA(1, 1), a1 + hstep, voffA);
            PG8_WAIT_L(8); PG8_BAR; PG8_WAIT_L(0); PG8_MMA(0, 0, At, B0); PG8_BAR; PG8_SCHED;
            PG8_LDB(B1, 0, 1); PG8_STAGE(PG8_SB(0, 0), b2, voffB);
            PG8_BAR; PG8_WAIT_L(0); PG8_MMA(0, 1, At, B1); PG8_BAR;
            PG8_LDA(At, 0, 1); PG8_STAGE(PG8_SA(0, 0), a2, voffA);
            PG8_BAR; PG8_WAIT_L(0); PG8_MMA(1, 0, At, B0); PG8_BAR; PG8_SCHED;
            PG8_STAGE(PG8_SB(0, 1), b2 + hstep, voffB);
            PG8_WAIT_V(6); PG8_BAR; PG8_MMA(1, 1, At, B1); PG8_BAR;
            PG8_LDB(B0, 1, 0); PG8_SCHED; PG8_LDA(At, 1, 0); PG8_STAGE(PG8_SA(0, 1), a2 + hstep, voffA);
            PG8_WAIT_L(8); PG8_BAR; PG8_WAIT_L(0); PG8_MMA(0, 0, At, B0); PG8_BAR; PG8_SCHED;
            PG8_LDB(B1, 1, 1); PG8_STAGE(PG8_SB(1, 0), b3, voffB);
            PG8_BAR; PG8_WAIT_L(0); PG8_MMA(0, 1, At, B1); PG8_BAR;
            PG8_LDA(At, 1, 1); PG8_STAGE(PG8_SA(1, 0), a3, voffA);
            PG8_BAR; PG8_WAIT_L(0); PG8_MMA(1, 0, At, B0); PG8_BAR; PG8_SCHED;
            PG8_STAGE(PG8_SB(1, 1), b3 + hstep, voffB);
            PG8_WAIT_V(6); PG8_BAR; PG8_MMA(1, 1, At, B1); PG8_BAR;
            }
        }
        if constexpr (ALIGN_EPI) { if (wr == 0) PG8_BAR; }
        if constexpr (!Epi::AFTER_DRAIN) { E(acc, cur, wr, wc, fr, fq); S.done(cur); }
        if (!has_next) break;
#pragma unroll
        for (int a = 0; a < 2; ++a)
#pragma unroll
            for (int b = 0; b < 2; ++b)
#pragma unroll
                for (int m = 0; m < 4; ++m)
#pragma unroll
                    for (int n = 0; n < 2; ++n) acc[a][b][m][n] = (f32x4){0.f, 0.f, 0.f, 0.f};
        cur = nxt; cA = nA; cB = nB; ++ui;
        if constexpr (ALIGN_EPI) { if (wr == 1) PG8_BAR; }
    }
    PG8_WAIT_V(0);
    if constexpr (!ALIGN_EPI) { if (wr == 0) PG8_BAR; }
    PG8_BAR;
    if constexpr (Epi::AFTER_DRAIN) { E.fused(acc, cur, wr, wc, fr, fq, lds, wid, lane); S.done(cur); }
#undef PG8_SA
#undef PG8_SB
#undef PG8_STAGE
#undef PG8_LDA
#undef PG8_LDB
#undef PG8_MMA
#undef PG8_WAIT_V
#undef PG8_WAIT_L
#undef PG8_BAR
#undef PG8_SCHED
}
}

#ifndef MK_PER_PHASE
#define MK_PER_PHASE 0
#endif
#define LAS __attribute__((address_space(3)))
using pg8::bf16_t; using pg8::f32x4; using pg8::u32x4; using pg8::bf16x8; using pg8::Unit;
typedef unsigned u32x2 __attribute__((ext_vector_type(2)));
typedef float f32x2v __attribute__((ext_vector_type(2)));
typedef __bf16 b16x2v __attribute__((ext_vector_type(2)));
typedef float f32x16 __attribute__((ext_vector_type(16)));
typedef short s16x4 __attribute__((ext_vector_type(4)));

constexpr int DM = 1024, SEQ = 2048, NBATCH = 8, NPT = NBATCH * SEQ, DECB = 128, DECS = 4, NST = DECB * DECS, MT = NPT + NST;
constexpr int NMEM = 256, MEMROWS = NBATCH * NMEM, DFF = 4096, DIN = 1536, DC = 512;
constexpr float LN_EPS = 1e-5f, DN_ALPHA = 1.18920711500272f;
constexpr int NPHASE = 10;

constexpr size_t OY = 0, OMK = (size_t)MT * DM, OMV = OMK + (size_t)MEMROWS * DM, OCP = OMV + (size_t)MEMROWS * DM, OCS = OCP + (size_t)NBATCH * 30 * 512,
                 OPP = OCS + (size_t)DECB * 30 * 512, OPS = OPP + (size_t)NBATCH * 15 * 512, OEND = OPS + (size_t)DECB * 15 * 512;
constexpr size_t MiB = 1u << 20;
constexpr size_t WS_CTL = 0, CTL_ZERO_BYTES = 512 * 1024;
constexpr size_t WS_WIN = 2 * MiB, WS_WKV = 5 * MiB, WS_WOUT = 9 * MiB, WS_WQ = 11 * MiB, WS_WO = 13 * MiB, WS_W1 = 15 * MiB, WS_W2 = 23 * MiB;
constexpr size_t WS_KB = 31 * MiB, WS_VT = 35 * MiB, WS_MB = 39 * MiB;
constexpr size_t WS_XB = 44 * MiB, WS_U = 77 * MiB, WS_P = WS_U + (size_t)MT * DC * 2, WS_MIX = 110 * MiB, WS_R1B = 143 * MiB, WS_Q = 176 * MiB, WS_O = 209 * MiB;
constexpr size_t WS_R1 = 242 * MiB, WS_R2 = 308 * MiB, WS_R2B = 374 * MiB, WS_END = 407 * MiB;
constexpr size_t WS_H = 44 * MiB;
static_assert(WS_H + (size_t)MT * DFF * 2 <= WS_Q, "H overlay");
constexpr int CF_ST1 = 0, CF_ST2 = 34816, CF_C1Q = 69632, CF_C2Q = 70656, CF_C1H = 71680, CF_C2H = 75776, CF_END = 79872;
static_assert(CF_END * 4 <= (int)CTL_ZERO_BYTES && MT * 2 <= CF_ST2, "ctl");

constexpr int LDS_BYTES = 131072 + 4096;

__device__ __forceinline__ unsigned pk2(float lo, float hi) { f32x2v v = {lo, hi}; b16x2v b = __builtin_convertvector(v, b16x2v); return __builtin_bit_cast(unsigned, b); }
__device__ __forceinline__ float bflo(unsigned v) { return __uint_as_float(v << 16); }
__device__ __forceinline__ float bfhi(unsigned v) { return __uint_as_float(v & 0xffff0000u); }
__device__ __forceinline__ float wave_sum(float v) {
#pragma unroll
    for (int o = 1; o < 64; o <<= 1) v += __shfl_xor(v, o);
    return v;
}
__device__ __forceinline__ float wave_max(float v) {
#pragma unroll
    for (int o = 1; o < 64; o <<= 1) v = fmaxf(v, __shfl_xor(v, o));
    return v;
}
__device__ __forceinline__ float fsigmoid(float x) { return __builtin_amdgcn_rcpf(1.0f + __expf(-x)); }

struct Args {
    const float* in[30]; float* outp; unsigned char* ws; int ph_lo, ph_hi;
    __device__ __forceinline__ const float* x_prompt() const { return in[0]; }
    __device__ __forceinline__ const float* x_sample() const { return in[1]; }
    __device__ __forceinline__ const float* mem_prompt() const { return in[2]; }
    __device__ __forceinline__ const float* cache_k() const { return in[3]; }
    __device__ __forceinline__ const float* cache_v() const { return in[4]; }
    __device__ __forceinline__ const float* state_conv() const { return in[5]; }
    __device__ __forceinline__ const float* state_pool() const { return in[6]; }
    __device__ __forceinline__ const float* w_in() const { return in[7]; }
    __device__ __forceinline__ const float* b_in() const { return in[8]; }
    __device__ __forceinline__ const float* conv_w() const { return in[9]; }
    __device__ __forceinline__ const float* conv_b() const { return in[10]; }
    __device__ __forceinline__ const float* gn_g() const { return in[11]; }
    __device__ __forceinline__ const float* gn_b() const { return in[12]; }
    __device__ __forceinline__ const float* pool_w() const { return in[13]; }
    __device__ __forceinline__ const float* pool_scale() const { return in[14]; }
    __device__ __forceinline__ const float* w_out() const { return in[15]; }
    __device__ __forceinline__ const float* ln1_g() const { return in[16]; }
    __device__ __forceinline__ const float* ln1_b() const { return in[17]; }
    __device__ __forceinline__ const float* xq_w() const { return in[18]; }
    __device__ __forceinline__ const float* xk_w() const { return in[19]; }
    __device__ __forceinline__ const float* xv_w() const { return in[20]; }
    __device__ __forceinline__ const float* xo_w() const { return in[21]; }
    __device__ __forceinline__ const float* ln2_g() const { return in[22]; }
    __device__ __forceinline__ const float* ln2_b() const { return in[23]; }
    __device__ __forceinline__ const float* w1() const { return in[24]; }
    __device__ __forceinline__ const float* b1() const { return in[25]; }
    __device__ __forceinline__ const float* w2() const { return in[26]; }
    __device__ __forceinline__ const float* b2() const { return in[27]; }
    __device__ __forceinline__ const float* ln3_g() const { return in[28]; }
    __device__ __forceinline__ const float* ln3_b() const { return in[29]; }
    __device__ __forceinline__ float* out() const { return outp; }
    __device__ __forceinline__ float* ctl() const { return (float*)(ws + WS_CTL); }
    __device__ __forceinline__ bf16_t* Win_t() const { return (bf16_t*)(ws + WS_WIN); }
    __device__ __forceinline__ bf16_t* Wkv_t() const { return (bf16_t*)(ws + WS_WKV); }
    __device__ __forceinline__ bf16_t* Wout_t() const { return (bf16_t*)(ws + WS_WOUT); }
    __device__ __forceinline__ bf16_t* Wq_t() const { return (bf16_t*)(ws + WS_WQ); }
    __device__ __forceinline__ bf16_t* Wo_t() const { return (bf16_t*)(ws + WS_WO); }
    __device__ __forceinline__ bf16_t* W1_t() const { return (bf16_t*)(ws + WS_W1); }
    __device__ __forceinline__ bf16_t* W2_t() const { return (bf16_t*)(ws + WS_W2); }
    __device__ __forceinline__ bf16_t* KB() const { return (bf16_t*)(ws + WS_KB); }
    __device__ __forceinline__ bf16_t* VT() const { return (bf16_t*)(ws + WS_VT); }
    __device__ __forceinline__ bf16_t* MB() const { return (bf16_t*)(ws + WS_MB); }
    __device__ __forceinline__ bf16_t* XB() const { return (bf16_t*)(ws + WS_XB); }
    __device__ __forceinline__ bf16_t* U() const { return (bf16_t*)(ws + WS_U); }
    __device__ __forceinline__ bf16_t* P() const { return (bf16_t*)(ws + WS_P); }
    __device__ __forceinline__ bf16_t* MIX() const { return (bf16_t*)(ws + WS_MIX); }
    __device__ __forceinline__ bf16_t* R1B() const { return (bf16_t*)(ws + WS_R1B); }
    __device__ __forceinline__ bf16_t* Q() const { return (bf16_t*)(ws + WS_Q); }
    __device__ __forceinline__ bf16_t* O() const { return (bf16_t*)(ws + WS_O); }
    __device__ __forceinline__ bf16_t* R2B() const { return (bf16_t*)(ws + WS_R2B); }
    __device__ __forceinline__ bf16_t* H() const { return (bf16_t*)(ws + WS_H); }
    __device__ __forceinline__ float* R1() const { return (float*)(ws + WS_R1); }
    __device__ __forceinline__ float* R2() const { return (float*)(ws + WS_R2); }
};

__device__ __forceinline__ int win_dest(int n) {
    if (n < 512) return 32 * (n >> 4) + (n & 15);
    if (n < 1024) { const int c = n - 512; return 32 * (c >> 4) + 16 + (c & 15); }
    return n;
}
template <int MODE>
__device__ __forceinline__ void tr_item(const float* __restrict__ W, int N, bf16_t* WT, int ldk, int row_off, LAS float* scr, int kb, int nb, int lane,
                                        const float* g, const float* b, float* c1, float* c2) {
    const int k0 = 64 * kb, n0 = 32 * nb;
    float tv[32];
#pragma unroll
    for (int i = 0; i < 32; ++i) tv[i] = W[(size_t)(k0 + 2 * i + (lane >> 5)) * N + n0 + (lane & 31)];
#pragma unroll
    for (int i = 0; i < 32; ++i) scr[(2 * i + (lane >> 5)) * 33 + (lane & 31)] = tv[i];
    asm volatile("s_waitcnt lgkmcnt(0)" ::: "memory");
    if (MODE == 2) {
        const float* vec = (lane < 32) ? g : b; float s = 0.f;
#pragma unroll 8
        for (int k = 0; k < 64; ++k) s += vec[k0 + k] * scr[k * 33 + (lane & 31)];
        atomicAdd(((lane < 32) ? c1 : c2) + n0 + (lane & 31), s);
    }
    const int c = lane & 7;
    float gs[8];
#pragma unroll
    for (int i = 0; i < 8; ++i) gs[i] = (MODE == 2) ? g[k0 + 8 * c + i] : 1.0f;
#pragma unroll
    for (int j = 0; j < 4; ++j) { const int n = (lane >> 3) + 8 * j; const LAS float* s = scr + (8 * c) * 33 + n;
        u32x4 o; o.x = pk2(s[0 * 33] * gs[0], s[1 * 33] * gs[1]); o.y = pk2(s[2 * 33] * gs[2], s[3 * 33] * gs[3]); o.z = pk2(s[4 * 33] * gs[4], s[5 * 33] * gs[5]); o.w = pk2(s[6 * 33] * gs[6], s[7 * 33] * gs[7]);
        const int dr = (MODE == 1) ? win_dest(n0 + n) : (n0 + n);
        *(u32x4*)(WT + (size_t)(row_off + dr) * ldk + k0 + 8 * c) = o; }
    asm volatile("s_waitcnt lgkmcnt(0)" ::: "memory");
}
__device__ __forceinline__ void poolfold_block(const Args& p, LAS unsigned char* lds, int item, int tid) {
    const int g = item >> 5, nb = item & 31;
    LAS float* PW = (LAS float*)lds;
    LAS float* WO = (LAS float*)(lds + 128 * 132 * 4);
    const float* pw = p.pool_w() + (size_t)g * 16384;
#pragma unroll
    for (int i = 0; i < 8; ++i) { const int idx = tid + 512 * i; *(LAS f32x4*)(PW + (idx >> 5) * 132 + 4 * (idx & 31)) = ((const f32x4*)pw)[idx]; }
#pragma unroll
    for (int i = 0; i < 8; ++i) { const int idx = tid + 512 * i, d = idx >> 5, n = idx & 31; WO[idx] = p.w_out()[(size_t)(512 + 128 * g + d) * DM + 32 * nb + n] * p.pool_scale()[128 * g + d]; }
    __syncthreads();
    const int n = tid & 31, cg = tid >> 5;
    float acc[8];
#pragma unroll
    for (int j = 0; j < 8; ++j) acc[j] = 0.f;
#pragma unroll 4
    for (int d4 = 0; d4 < 32; ++d4) {
        const float w0 = WO[(4 * d4 + 0) * 32 + n], w1 = WO[(4 * d4 + 1) * 32 + n], w2 = WO[(4 * d4 + 2) * 32 + n], w3 = WO[(4 * d4 + 3) * 32 + n];
#pragma unroll
        for (int j = 0; j < 8; ++j) { const f32x4 q = *(const LAS f32x4*)(PW + (cg * 8 + j) * 132 + 4 * d4); acc[j] = fmaf(q[0], w0, fmaf(q[1], w1, fmaf(q[2], w2, fmaf(q[3], w3, acc[j])))); }
    }
    u32x4 o; o.x = pk2(acc[0], acc[1]); o.y = pk2(acc[2], acc[3]); o.z = pk2(acc[4], acc[5]); o.w = pk2(acc[6], acc[7]);
    *(u32x4*)(p.Wout_t() + (size_t)(32 * nb + n) * DM + 512 + 128 * g + cg * 8) = o;
    __syncthreads();
}
__device__ __forceinline__ void row_to_bf16(const float* xrow, bf16_t* orow, int lane) {
    const f32x4* xr = (const f32x4*)xrow + lane; unsigned long long* o8 = (unsigned long long*)orow + lane;
    f32x4 v[4];
#pragma unroll
    for (int j = 0; j < 4; ++j) v[j] = xr[64 * j];
#pragma unroll
    for (int j = 0; j < 4; ++j) o8[64 * j] = (unsigned long long)pk2(v[j].x, v[j].y) | ((unsigned long long)pk2(v[j].z, v[j].w) << 32);
}
__device__ __forceinline__ void p0_prologue(const Args& p, LAS unsigned char* lds, int G, int bid, int tid) {
    const int lane = tid & 63, wave = tid >> 6;
    LAS float* scr = (LAS float*)(lds + wave * 16384);
    const int gw = bid * 8 + wave, NGW = G * 8;
    constexpr int I_IN = 16 * 48, I_K = 16 * 32, I_V = I_K, I_OUT = 8 * 32, I_Q = I_K, I_O = I_K, I_1 = 16 * 128, I_2 = 64 * 32;
    constexpr int NITEMS = I_IN + I_K + I_V + I_OUT + I_Q + I_O + I_1 + I_2;
    for (int it = bid; it < 128; it += G) poolfold_block(p, lds, it, tid);
    for (int it = gw; it < NITEMS; it += NGW) {
        int r = it;
        if (r < I_IN) { tr_item<1>(p.w_in(), DIN, p.Win_t(), DM, 0, scr, r / 48, r % 48, lane, nullptr, nullptr, nullptr, nullptr); continue; } r -= I_IN;
        if (r < I_K) { tr_item<0>(p.xk_w(), DM, p.Wkv_t(), DM, 0, scr, r / 32, r % 32, lane, nullptr, nullptr, nullptr, nullptr); continue; } r -= I_K;
        if (r < I_V) { tr_item<0>(p.xv_w(), DM, p.Wkv_t(), DM, DM, scr, r / 32, r % 32, lane, nullptr, nullptr, nullptr, nullptr); continue; } r -= I_V;
        if (r < I_OUT) { tr_item<0>(p.w_out(), DM, p.Wout_t(), DM, 0, scr, r / 32, r % 32, lane, nullptr, nullptr, nullptr, nullptr); continue; } r -= I_OUT;
        if (r < I_Q) { tr_item<2>(p.xq_w(), DM, p.Wq_t(), DM, 0, scr, r / 32, r % 32, lane, p.ln1_g(), p.ln1_b(), p.ctl() + CF_C1Q, p.ctl() + CF_C2Q); continue; } r -= I_Q;
        if (r < I_O) { tr_item<0>(p.xo_w(), DM, p.Wo_t(), DM, 0, scr, r / 32, r % 32, lane, nullptr, nullptr, nullptr, nullptr); continue; } r -= I_O;
        if (r < I_1) { tr_item<2>(p.w1(), DFF, p.W1_t(), DM, 0, scr, r / 128, r % 128, lane, p.ln2_g(), p.ln2_b(), p.ctl() + CF_C1H, p.ctl() + CF_C2H); continue; } r -= I_1;
        tr_item<0>(p.w2(), DM, p.W2_t(), DFF, 0, scr, r / 32, r % 32, lane, nullptr, nullptr, nullptr, nullptr);
    }
    const int gt = bid * 512 + tid, NT = G * 512;
#define CVT_REGION(src, dst, n4) do { const f32x4* s4_ = (const f32x4*)(src); unsigned long long* d8_ = (unsigned long long*)(dst); \
        _Pragma("unroll 4") for (int i_ = gt; i_ < (n4); i_ += NT) { const f32x4 v_ = s4_[i_]; d8_[i_] = (unsigned long long)pk2(v_.x, v_.y) | ((unsigned long long)pk2(v_.z, v_.w) << 32); } } while (0)
    CVT_REGION(p.x_prompt(), p.XB(), NPT * (DM / 4));
    CVT_REGION(p.x_sample(), p.XB() + (size_t)NPT * DM, NST * (DM / 4));
    CVT_REGION(p.mem_prompt(), p.MB(), MEMROWS * (DM / 4));
#undef CVT_REGION
    for (int i = gt; i < DECB * 3328; i += NT) { const int sb = i / 3328, o = i % 3328; ((f32x4*)(p.out() + OCS + (size_t)sb * 15360))[o] = ((const f32x4*)(p.state_conv() + (size_t)sb * 15360 + 2048))[o]; }
    for (int i = gt; i < DECB * 1408; i += NT) { const int sb = i / 1408, o = i % 1408; ((f32x4*)(p.out() + OPS + (size_t)sb * 7680))[o] = ((const f32x4*)(p.state_pool() + (size_t)sb * 7680 + 2048))[o]; }
}

struct EpiIn {
    static constexpr bool PERM = false, AFTER_DRAIN = false;
    const float* b_in; bf16_t* U; bf16_t* P; float* out;
    __device__ __forceinline__ void operator()(const f32x4 (&acc)[2][2][4][2], const Unit& u, int wr, int wc, int fr, int fq) const {
        if (u.pn < 4) {
#pragma unroll
            for (int bj = 0; bj < 2; ++bj) {
                const int ch = 16 * (8 * u.pn + 4 * bj + wc) + 4 * fq;
                const f32x4 ba = *(const f32x4*)(b_in + ch), bg = *(const f32x4*)(b_in + 512 + ch);
#pragma unroll
                for (int ai = 0; ai < 2; ++ai)
#pragma unroll
                    for (int m = 0; m < 4; ++m) {
                        const int row = u.pm * 256 + ai * 128 + wr * 64 + m * 16 + fr;
                        const f32x4 av = acc[ai][bj][m][0] + ba, gv = acc[ai][bj][m][1] + bg; f32x4 uv;
#pragma unroll
                        for (int e = 0; e < 4; ++e) uv[e] = av[e] * fsigmoid(gv[e]);
                        u32x2 w; w.x = pk2(uv[0], uv[1]); w.y = pk2(uv[2], uv[3]);
                        *(u32x2*)(U + (size_t)row * DC + ch) = w;
                        if (row < NPT) { const int t = row & (SEQ - 1); if (t >= SEQ - 30) *(f32x4*)(out + OCP + ((size_t)(row >> 11) * 30 + (t - (SEQ - 30))) * 512 + ch) = uv; }
                        else { const int s = row - NPT; *(f32x4*)(out + OCS + ((size_t)(s >> 2) * 30 + 26 + (s & 3)) * 512 + ch) = uv; }
                    }
            }
        } else {
#pragma unroll
            for (int bj = 0; bj < 2; ++bj)
#pragma unroll
                for (int n = 0; n < 2; ++n) {
                    const int pc = 256 * (u.pn - 4) + 128 * bj + 32 * wc + 16 * n + 4 * fq;
                    const f32x4 bp = *(const f32x4*)(b_in + 1024 + pc);
#pragma unroll
                    for (int ai = 0; ai < 2; ++ai)
#pragma unroll
                        for (int m = 0; m < 4; ++m) {
                            const int row = u.pm * 256 + ai * 128 + wr * 64 + m * 16 + fr;
                            const f32x4 pv = acc[ai][bj][m][n] + bp;
                            u32x2 w; w.x = pk2(pv[0], pv[1]); w.y = pk2(pv[2], pv[3]);
                            *(u32x2*)(P + (size_t)row * DC + pc) = w;
                            if (row < NPT) { const int t = row & (SEQ - 1); if (t >= SEQ - 15) *(f32x4*)(out + OPP + ((size_t)(row >> 11) * 15 + (t - (SEQ - 15))) * 512 + pc) = pv; }
                            else { const int s = row - NPT; *(f32x4*)(out + OPS + ((size_t)(s >> 2) * 15 + 11 + (s & 3)) * 512 + pc) = pv; }
                        }
                }
        }
    }
};
struct EpiKV {
    static constexpr bool PERM = false, AFTER_DRAIN = false;
    float* out; bf16_t* KB; bf16_t* VT;
    __device__ __forceinline__ void operator()(const f32x4 (&acc)[2][2][4][2], const Unit& u, int wr, int wc, int fr, int fq) const {
#pragma unroll
        for (int bj = 0; bj < 2; ++bj)
#pragma unroll
            for (int n = 0; n < 2; ++n) {
                const int col = u.pn * 256 + 128 * bj + 32 * wc + 16 * n + 4 * fq;
#pragma unroll
                for (int ai = 0; ai < 2; ++ai)
#pragma unroll
                    for (int m = 0; m < 4; ++m) {
                        const int row = u.pm * 256 + ai * 128 + wr * 64 + m * 16 + fr;
                        const f32x4 v = acc[ai][bj][m][n];
                        if (u.pn < 4) {
                            *(f32x4*)(out + OMK + (size_t)row * DM + col) = v;
                            u32x2 w; w.x = pk2(v[0], v[1]); w.y = pk2(v[2], v[3]);
                            *(u32x2*)(KB + (size_t)row * DM + col) = w;
                        } else {
                            const int c = col - DM;
                            *(f32x4*)(out + OMV + (size_t)row * DM + c) = v;
                            const int b = row >> 8, key = row & 255, h = c >> 8, d = c & 255;
                            bf16_t* vt = VT + ((size_t)((b * 4 + h) * 256 + d)) * 256 + key;
                            const unsigned w0 = pk2(v[0], v[1]), w1 = pk2(v[2], v[3]);
                            vt[0] = (bf16_t)(w0 & 0xffffu); vt[256] = (bf16_t)(w0 >> 16); vt[512] = (bf16_t)(w1 & 0xffffu); vt[768] = (bf16_t)(w1 >> 16);
                        }
                    }
            }
    }
};
template <int MODE, bool HAS_F32, bool HAS_BF, bool HAS_STATS, bool HAS_BIAS>
struct EpiRes {
    static constexpr bool PERM = false, AFTER_DRAIN = false;
    const bf16_t* xb; const float* stp; const float* g; const float* b;
    float* Rout; bf16_t* Rb; float* st; const float* bias;
    __device__ __forceinline__ void operator()(const f32x4 (&acc)[2][2][4][2], const Unit& u, int wr, int wc, int fr, int fq) const {
        const int colb = u.pn * 256 + 32 * wc + 4 * fq;
        f32x4 g4[2][2], b4[2][2], bi4[2][2];
#pragma unroll
        for (int bj = 0; bj < 2; ++bj)
#pragma unroll
            for (int n = 0; n < 2; ++n) { const int col = colb + 128 * bj + 16 * n;
                if (MODE == 1) { g4[bj][n] = *(const f32x4*)(g + col); b4[bj][n] = *(const f32x4*)(b + col); }
                if (HAS_BIAS) bi4[bj][n] = *(const f32x4*)(bias + col); }
#pragma unroll
        for (int ai = 0; ai < 2; ++ai)
#pragma unroll
            for (int m = 0; m < 4; ++m) {
                const int row = u.pm * 256 + ai * 128 + wr * 64 + m * 16 + fr;
                float mu = 0.f, rs = 1.f;
                if (MODE == 1) { const f32x2v s2 = *(const f32x2v*)(stp + 2 * row); mu = s2.x * (1.0f / DM); rs = rsqrtf(fmaxf(s2.y * (1.0f / DM) - mu * mu, 0.f) + LN_EPS); }
                const bf16_t* xrow = xb + (size_t)row * DM;
                float sum = 0.f, sq = 0.f;
#pragma unroll
                for (int bj = 0; bj < 2; ++bj)
#pragma unroll
                    for (int n = 0; n < 2; ++n) { const int col = colb + 128 * bj + 16 * n;
                        const u32x2 xw = *(const u32x2*)(xrow + col); f32x4 xv = {bflo(xw.x), bfhi(xw.x), bflo(xw.y), bfhi(xw.y)};
                        if (MODE == 1) xv = (xv - mu) * rs * g4[bj][n] + b4[bj][n];
                        f32x4 r = xv * DN_ALPHA + acc[ai][bj][m][n];
                        if (HAS_BIAS) r = r + bi4[bj][n];
                        if (HAS_F32) *(f32x4*)(Rout + (size_t)row * DM + col) = r;
                        if (HAS_BF) { u32x2 w; w.x = pk2(r[0], r[1]); w.y = pk2(r[2], r[3]); *(u32x2*)(Rb + (size_t)row * DM + col) = w; }
                        if (HAS_STATS) { sum += (r[0] + r[1]) + (r[2] + r[3]); sq += (r[0] * r[0] + r[1] * r[1]) + (r[2] * r[2] + r[3] * r[3]); }
                    }
                if (HAS_STATS) {
                    sum += __shfl_xor(sum, 16); sum += __shfl_xor(sum, 32); sq += __shfl_xor(sq, 16); sq += __shfl_xor(sq, 32);
                    if (fq == 0) { atomicAdd(st + 2 * row, sum); atomicAdd(st + 2 * row + 1, sq); }
                }
            }
    }
};
template <int ACT  , bool HAS_BIAS>
struct EpiFold {
    static constexpr bool PERM = true, AFTER_DRAIN = false;
    bf16_t* O; int ldc; const float* stp; const float* c1; const float* c2; const float* bias; float scale;
    __device__ __forceinline__ void operator()(const f32x4 (&acc)[2][2][4][2], const Unit& u, int wr, int wc, int fr, int fq) const {
        const int colb = u.pn * 256 + 32 * wc + 8 * fq;
        f32x4 c1v[2][2], c2v[2][2];
#pragma unroll
        for (int bj = 0; bj < 2; ++bj)
#pragma unroll
            for (int n = 0; n < 2; ++n) { const int col = colb + 128 * bj + 4 * n; c1v[bj][n] = *(const f32x4*)(c1 + col); c2v[bj][n] = *(const f32x4*)(c2 + col);
                if (HAS_BIAS) c2v[bj][n] = c2v[bj][n] + *(const f32x4*)(bias + col); }
#pragma unroll
        for (int ai = 0; ai < 2; ++ai)
#pragma unroll
            for (int m = 0; m < 4; ++m) {
                const int row = u.pm * 256 + ai * 128 + wr * 64 + m * 16 + fr;
                const f32x2v s2 = *(const f32x2v*)(stp + 2 * row); const float mu = s2.x * (1.0f / DM); const float rs = rsqrtf(fmaxf(s2.y * (1.0f / DM) - mu * mu, 0.f) + LN_EPS);
#pragma unroll
                for (int bj = 0; bj < 2; ++bj) {
                    f32x4 v0 = (acc[ai][bj][m][0] - c1v[bj][0] * mu) * rs + c2v[bj][0], v1 = (acc[ai][bj][m][1] - c1v[bj][1] * mu) * rs + c2v[bj][1];
                    if (ACT == 1) {
#pragma unroll
                        for (int e = 0; e < 4; ++e) { const float a = fmaxf(v0[e], 0.f), c = fmaxf(v1[e], 0.f); v0[e] = a * a; v1[e] = c * c; }
                    }
                    v0 = v0 * scale; v1 = v1 * scale;
                    u32x4 w; w.x = pk2(v0[0], v0[1]); w.y = pk2(v0[2], v0[3]); w.z = pk2(v1[0], v1[1]); w.w = pk2(v1[2], v1[3]);
                    *(u32x4*)(O + (size_t)row * ldc + colb + 128 * bj) = w;
                }
            }
    }
};

constexpr int SG_STRIDE = 528, SG_BOFF = 64 * SG_STRIDE;
template <class Epi>
__device__ __forceinline__ void small_gemm_phase(LAS unsigned char* lds, const bf16_t* A, const bf16_t* Bt, int K, int ld, int ncol64, const Epi& E, int first, int nblk, int bid, int tid) {
    const int lane = tid & 63, wid = tid >> 6, fr = lane & 15, fq = lane >> 4, mt = wid >> 1, nh = wid & 1;
    const int ub = bid - first; if (ub < 0 || ub >= nblk) return;
    const int nch = K >> 8;
    for (int u = ub; u < 8 * ncol64; u += nblk) {
        const int rt = u & 7, ct = u >> 3;
        const int row0 = NPT + 64 * rt, col0 = 64 * ct;
        u32x4 ra[4], rb[4];
#define SG_LOAD(kc) do { _Pragma("unroll") for (int i_ = 0; i_ < 4; ++i_) { const int idx_ = tid + 512 * i_; \
            ra[i_] = *(const u32x4*)(A + (size_t)(row0 + (idx_ >> 5)) * ld + (kc) * 256 + (idx_ & 31) * 8); rb[i_] = *(const u32x4*)(Bt + (size_t)(col0 + (idx_ >> 5)) * ld + (kc) * 256 + (idx_ & 31) * 8); } } while (0)
        SG_LOAD(0);
        f32x4 acc0 = {0.f, 0.f, 0.f, 0.f}, acc1 = {0.f, 0.f, 0.f, 0.f};
        const LAS unsigned char* apl = lds + (16 * mt + fr) * SG_STRIDE + 16 * fq;
        const LAS unsigned char* bpl = lds + SG_BOFF + (32 * nh + fr) * SG_STRIDE + 16 * fq;
#pragma unroll 1
        for (int kc = 0; kc < nch; ++kc) {
            __syncthreads();
#pragma unroll
            for (int i = 0; i < 4; ++i) { const int idx = tid + 512 * i; *(LAS u32x4*)(lds + (idx >> 5) * SG_STRIDE + (idx & 31) * 16) = ra[i]; *(LAS u32x4*)(lds + SG_BOFF + (idx >> 5) * SG_STRIDE + (idx & 31) * 16) = rb[i]; }
            if (kc + 1 < nch) SG_LOAD(kc + 1);
            __syncthreads();
#pragma unroll
            for (int s8 = 0; s8 < 8; ++s8) {
                const bf16x8 a = *(const LAS bf16x8*)(apl + s8 * 64), b0 = *(const LAS bf16x8*)(bpl + s8 * 64), b1 = *(const LAS bf16x8*)(bpl + 16 * SG_STRIDE + s8 * 64);
                acc0 = __builtin_amdgcn_mfma_f32_16x16x32_bf16(b0, a, acc0, 0, 0, 0);
                acc1 = __builtin_amdgcn_mfma_f32_16x16x32_bf16(b1, a, acc1, 0, 0, 0);
            }
        }
#undef SG_LOAD
        E(row0 + 16 * mt + fr, col0 + 32 * nh, fq, acc0, acc1);
    }
    __syncthreads();
}
struct SmallIn {
    const float* b_in; bf16_t* U; bf16_t* P; float* out;
    __device__ __forceinline__ void operator()(int row, int colb, int fq, f32x4 acc0, f32x4 acc1) const {
        const int s = row - NPT;
        if (colb < 1024) {
            const int ch = 16 * (colb >> 5) + 4 * fq;
            const f32x4 av = acc0 + *(const f32x4*)(b_in + ch), gv = acc1 + *(const f32x4*)(b_in + 512 + ch); f32x4 uv;
#pragma unroll
            for (int e = 0; e < 4; ++e) uv[e] = av[e] * fsigmoid(gv[e]);
            u32x2 w; w.x = pk2(uv[0], uv[1]); w.y = pk2(uv[2], uv[3]);
            *(u32x2*)(U + (size_t)row * DC + ch) = w;
            *(f32x4*)(out + OCS + ((size_t)(s >> 2) * 30 + 26 + (s & 3)) * 512 + ch) = uv;
        } else {
#pragma unroll
            for (int t = 0; t < 2; ++t) { const int pc = colb - 1024 + 16 * t + 4 * fq; const f32x4 pv = (t ? acc1 : acc0) + *(const f32x4*)(b_in + 1024 + pc);
                u32x2 w; w.x = pk2(pv[0], pv[1]); w.y = pk2(pv[2], pv[3]);
                *(u32x2*)(P + (size_t)row * DC + pc) = w;
                *(f32x4*)(out + OPS + ((size_t)(s >> 2) * 15 + 11 + (s & 3)) * 512 + pc) = pv; }
        }
    }
};
template <int MODE, bool HAS_F32, bool HAS_BF, bool HAS_STATS, bool HAS_BIAS>
struct SmallRes {
    const bf16_t* xb; const float* stp; const float* g; const float* b;
    float* Rout; bf16_t* Rb; float* st; const float* bias;
    __device__ __forceinline__ void operator()(int row, int colb, int fq, f32x4 acc0, f32x4 acc1) const {
        float mu = 0.f, rs = 1.f;
        if (MODE == 1) { const f32x2v s2 = *(const f32x2v*)(stp + 2 * row); mu = s2.x * (1.0f / DM); rs = rsqrtf(fmaxf(s2.y * (1.0f / DM) - mu * mu, 0.f) + LN_EPS); }
        const bf16_t* xrow = xb + (size_t)row * DM;
        float sum = 0.f, sq = 0.f;
#pragma unroll
        for (int t = 0; t < 2; ++t) { const int col = colb + 16 * t + 4 * fq;
            const u32x2 xw = *(const u32x2*)(xrow + col); f32x4 xv = {bflo(xw.x), bfhi(xw.x), bflo(xw.y), bfhi(xw.y)};
            if (MODE == 1) xv = (xv - mu) * rs * *(const f32x4*)(g + col) + *(const f32x4*)(b + col);
            f32x4 r = xv * DN_ALPHA + (t ? acc1 : acc0);
            if (HAS_BIAS) r = r + *(const f32x4*)(bias + col);
            if (HAS_F32) *(f32x4*)(Rout + (size_t)row * DM + col) = r;
            if (HAS_BF) { u32x2 w; w.x = pk2(r[0], r[1]); w.y = pk2(r[2], r[3]); *(u32x2*)(Rb + (size_t)row * DM + col) = w; }
            if (HAS_STATS) { sum += (r[0] + r[1]) + (r[2] + r[3]); sq += (r[0] * r[0] + r[1] * r[1]) + (r[2] * r[2] + r[3] * r[3]); } }
        if (HAS_STATS) {
            sum += __shfl_xor(sum, 16); sum += __shfl_xor(sum, 32); sq += __shfl_xor(sq, 16); sq += __shfl_xor(sq, 32);
            if (fq == 0) { atomicAdd(st + 2 * row, sum); atomicAdd(st + 2 * row + 1, sq); }
        }
    }
};
template <int ACT, bool HAS_BIAS>
struct SmallFold {
    bf16_t* O; int ldc; const float* stp; const float* c1; const float* c2; const float* bias; float scale;
    __device__ __forceinline__ void operator()(int row, int colb, int fq, f32x4 acc0, f32x4 acc1) const {
        const f32x2v s2 = *(const f32x2v*)(stp + 2 * row); const float mu = s2.x * (1.0f / DM); const float rs = rsqrtf(fmaxf(s2.y * (1.0f / DM) - mu * mu, 0.f) + LN_EPS);
#pragma unroll
        for (int t = 0; t < 2; ++t) { const int col = colb + 16 * t + 4 * fq;
            f32x4 c2v = *(const f32x4*)(c2 + col); if (HAS_BIAS) c2v = c2v + *(const f32x4*)(bias + col);
            f32x4 v = ((t ? acc1 : acc0) - *(const f32x4*)(c1 + col) * mu) * rs + c2v;
            if (ACT == 1) {
#pragma unroll
                for (int e = 0; e < 4; ++e) { const float a = fmaxf(v[e], 0.f); v[e] = a * a; }
            }
            v = v * scale;
            u32x2 w; w.x = pk2(v[0], v[1]); w.y = pk2(v[2], v[3]);
            *(u32x2*)(O + (size_t)row * ldc + col) = w; }
    }
};

__device__ __forceinline__ void gn_swish_store(float v0, float v1, f32x2v gg, f32x2v gb, unsigned* dst) {
    float s = v0 + v1;
#pragma unroll
    for (int o = 1; o < 32; o <<= 1) s += __shfl_xor(s, o);
    const float mean = s * (1.0f / 64.0f); const float d0 = v0 - mean, d1 = v1 - mean;
    float q = d0 * d0 + d1 * d1;
#pragma unroll
    for (int o = 1; o < 32; o <<= 1) q += __shfl_xor(q, o);
    const float rstd = rsqrtf(q * (1.0f / 64.0f) + LN_EPS);
    float y0 = d0 * rstd * gg.x + gb.x, y1 = d1 * rstd * gg.y + gb.y;
    y0 = y0 * fsigmoid(y0); y1 = y1 * fsigmoid(y1);
    *dst = pk2(y0, y1);
}
__device__ __forceinline__ void mixer_prompt_run(const Args& p, int run, int c2) {
    const int b = run >> 7, t0 = (run & 127) * 16;
    const unsigned* U32 = (const unsigned*)p.U(); const unsigned* P32 = (const unsigned*)p.P(); unsigned* M32 = (unsigned*)p.MIX();
    const size_t rowb = (size_t)b * SEQ;
    {
        unsigned pin[31];
#pragma unroll
        for (int i = 0; i < 31; ++i) { const int t = t0 - 15 + i; const unsigned v = P32[(rowb + (t >= 0 ? t : 0)) * 256 + c2]; pin[i] = (t >= 0) ? v : 0u; }
        const int w = 2 << (c2 >> 6);
#pragma unroll
        for (int t = 0; t < 16; ++t) { float s0 = 0.f, s1 = 0.f;
#pragma unroll
            for (int i = 0; i < 16; ++i) { const unsigned v = (i < w) ? pin[15 + t - i] : 0u; s0 += bflo(v); s1 += bfhi(v); }
            const float cnt = (float)min(t0 + t + 1, w); const unsigned cur = pin[15 + t];
            M32[(rowb + t0 + t) * 512 + 256 + c2] = pk2(s0 / cnt - bflo(cur), s1 / cnt - bfhi(cur)); }
    }
    asm volatile("" ::: "memory");
    {
        float w0[31], w1[31];
#pragma unroll
        for (int j = 0; j < 31; ++j) { const f32x2v w = *(const f32x2v*)(p.conv_w() + j * 512 + 2 * c2); w0[j] = w.x; w1[j] = w.y; }
        const f32x2v cb = *(const f32x2v*)(p.conv_b() + 2 * c2);
        const f32x2v gg = *(const f32x2v*)(p.gn_g() + 2 * c2), gb = *(const f32x2v*)(p.gn_b() + 2 * c2);
#pragma unroll 1
        for (int hh = 0; hh < 2; ++hh) {
            float a0[8], a1[8];
#pragma unroll
            for (int t = 0; t < 8; ++t) { a0[t] = cb.x; a1[t] = cb.y; }
#pragma unroll
            for (int i = 0; i < 38; ++i) {
                const int ti = t0 + 8 * hh - 30 + i; unsigned v = U32[(rowb + (ti >= 0 ? ti : 0)) * 256 + c2]; v = (ti >= 0) ? v : 0u; const float x0 = bflo(v), x1 = bfhi(v);
#pragma unroll
                for (int t = 0; t < 8; ++t) { const int j = i - t; if (j >= 0 && j <= 30) { a0[t] = fmaf(w0[j], x0, a0[t]); a1[t] = fmaf(w1[j], x1, a1[t]); } }
                if ((i & 7) == 7) asm volatile("" ::: "memory");
            }
#pragma unroll
            for (int t = 0; t < 8; ++t) gn_swish_store(a0[t], a1[t], gg, gb, M32 + (rowb + t0 + 8 * hh + t) * 512 + c2);
            asm volatile("" ::: "memory");
        }
    }
}
__device__ __forceinline__ void mixer_sample_run(const Args& p, int sb, int c2) {
    const unsigned* U32 = (const unsigned*)p.U(); const unsigned* P32 = (const unsigned*)p.P(); unsigned* M32 = (unsigned*)p.MIX();
    const size_t rowb = (size_t)NPT + (size_t)sb * DECS;
    {
        float w0[31], w1[31];
#pragma unroll
        for (int j = 0; j < 31; ++j) { const f32x2v w = *(const f32x2v*)(p.conv_w() + j * 512 + 2 * c2); w0[j] = w.x; w1[j] = w.y; }
        const f32x2v cb = *(const f32x2v*)(p.conv_b() + 2 * c2);
        float a0[4], a1[4];
#pragma unroll
        for (int t = 0; t < 4; ++t) { a0[t] = cb.x; a1[t] = cb.y; }
#pragma unroll
        for (int i = 0; i < 34; ++i) {
            float x0, x1;
            if (i < 30) { const f32x2v v = *(const f32x2v*)(p.state_conv() + ((size_t)sb * 30 + i) * 512 + 2 * c2); x0 = v.x; x1 = v.y; }
            else { const unsigned v = U32[(rowb + (i - 30)) * 256 + c2]; x0 = bflo(v); x1 = bfhi(v); }
#pragma unroll
            for (int t = 0; t < 4; ++t) { const int j = i - t; if (j >= 0 && j <= 30) { a0[t] = fmaf(w0[j], x0, a0[t]); a1[t] = fmaf(w1[j], x1, a1[t]); } }
        }
        const f32x2v gg = *(const f32x2v*)(p.gn_g() + 2 * c2), gb = *(const f32x2v*)(p.gn_b() + 2 * c2);
#pragma unroll
        for (int t = 0; t < 4; ++t) gn_swish_store(a0[t], a1[t], gg, gb, M32 + (rowb + t) * 512 + c2);
    }
    {
        float q0[19], q1[19];
#pragma unroll
        for (int i = 0; i < 15; ++i) { const f32x2v v = *(const f32x2v*)(p.state_pool() + ((size_t)sb * 15 + i) * 512 + 2 * c2); q0[i] = v.x; q1[i] = v.y; }
#pragma unroll
        for (int t = 0; t < 4; ++t) { const unsigned v = P32[(rowb + t) * 256 + c2]; q0[15 + t] = bflo(v); q1[15 + t] = bfhi(v); }
        const int w = 2 << (c2 >> 6); const float cnt = (float)w;
#pragma unroll
        for (int t = 0; t < 4; ++t) { float s0 = 0.f, s1 = 0.f;
#pragma unroll
            for (int i = 0; i < 16; ++i) { if (i < w) { s0 += q0[15 + t - i]; s1 += q1[15 + t - i]; } }
            M32[(rowb + t) * 512 + 256 + c2] = pk2(s0 / cnt - q0[15 + t], s1 / cnt - q1[15 + t]); }
    }
}
__device__ __forceinline__ void p2_mixer(const Args& p, int G, int bid, int tid) {
    const int half = __builtin_amdgcn_readfirstlane(tid >> 8), c2 = tid & 255;
    for (int it = bid; it < 512 + 64; it += G) {
        if (it < 512) mixer_prompt_run(p, 2 * it + half, c2);
        else mixer_sample_run(p, 2 * (it - 512) + half, c2);
    }
}

#define MFMA32(a, b, c) __builtin_amdgcn_mfma_f32_32x32x16_bf16((a), (b), (c), 0, 0, 0)
constexpr int AT_STRIDE = 528;
__device__ __forceinline__ void attn_prompt_unit(const Args& p, LAS unsigned char* lds, int unit, int tid) {
    const int lane = tid & 63, wid = tid >> 6, r = lane & 31, hi = lane >> 5;
    const int b = unit >> 5, h = (unit >> 3) & 3, qb = unit & 7;
    const size_t qrow = (size_t)b * SEQ + qb * 256 + wid * 32 + r;
    bf16x8 qf[8];
    LAS bf16x8* qlds = (LAS bf16x8*)(lds + 17408 + wid * 8192) + lane;
    { const bf16_t* qp = p.Q() + qrow * DM + h * 256 + 8 * hi;
#pragma unroll
      for (int ks = 0; ks < 8; ++ks) qf[ks] = *(const bf16x8*)(qp + ks * 16);
#pragma unroll
      for (int ks = 0; ks < 8; ++ks) qlds[ks * 64] = *(const bf16x8*)(qp + (8 + ks) * 16); }
    const bf16_t* kbase = p.KB() + (size_t)(b * NMEM) * DM + h * 256;
    const bf16_t* vbase = p.VT() + (size_t)((b * 4 + h) * 256) * 256;
    u32x4 stg[2];
    f32x16 st[8];
#pragma unroll
    for (int t = 0; t < 8; ++t)
#pragma unroll
        for (int i = 0; i < 16; ++i) st[t][i] = 0.f;
#define AT_LOADK(kt) do { _Pragma("unroll") for (int i_ = 0; i_ < 2; ++i_) { const int idx_ = tid + 512 * i_; stg[i_] = *(const u32x4*)(kbase + (size_t)((kt) * 32 + (idx_ >> 5)) * DM + (idx_ & 31) * 8); } } while (0)
#define AT_LOADV(dt) do { _Pragma("unroll") for (int i_ = 0; i_ < 2; ++i_) { const int idx_ = tid + 512 * i_; stg[i_] = *(const u32x4*)(vbase + (size_t)((dt) * 32 + (idx_ >> 5)) * 256 + (idx_ & 31) * 8); } } while (0)
#define AT_WRITE() do { _Pragma("unroll") for (int i_ = 0; i_ < 2; ++i_) { const int idx_ = tid + 512 * i_; *(LAS u32x4*)(lds + (idx_ >> 5) * AT_STRIDE + (idx_ & 31) * 16) = stg[i_]; } } while (0)
    AT_LOADK(0);
#pragma unroll
    for (int kt = 0; kt < 8; ++kt) {
        __syncthreads();
        AT_WRITE();
        if (kt < 7) AT_LOADK(kt + 1); else AT_LOADV(0);
        __syncthreads();
        const LAS unsigned char* ap = lds + r * AT_STRIDE + hi * 16;
#pragma unroll
        for (int ks = 0; ks < 8; ++ks) { const bf16x8 a = *(const LAS bf16x8*)(ap + ks * 32); st[kt] = MFMA32(a, qf[ks], st[kt]); }
#pragma unroll
        for (int ks = 0; ks < 8; ++ks) { const bf16x8 a = *(const LAS bf16x8*)(ap + (8 + ks) * 32); const bf16x8 qb8 = qlds[ks * 64]; st[kt] = MFMA32(a, qb8, st[kt]); }
    }
    float mx = -3.0e38f;
#pragma unroll
    for (int t = 0; t < 8; ++t)
#pragma unroll
        for (int i = 0; i < 16; ++i) mx = fmaxf(mx, st[t][i]);
    mx = fmaxf(mx, __shfl_xor(mx, 32));
    float sum = 0.f;
#pragma unroll
    for (int t = 0; t < 8; ++t)
#pragma unroll
        for (int i = 0; i < 16; ++i) { const float e = __expf(st[t][i] - mx); st[t][i] = e; sum += e; }
    sum += __shfl_xor(sum, 32);
    const float inv = 1.0f / sum;
    bf16x8 pf[16];
#pragma unroll
    for (int t = 0; t < 8; ++t)
#pragma unroll
        for (int s = 0; s < 2; ++s) { u32x4 w; w.x = pk2(st[t][8 * s + 0], st[t][8 * s + 1]); w.y = pk2(st[t][8 * s + 2], st[t][8 * s + 3]); w.z = pk2(st[t][8 * s + 4], st[t][8 * s + 5]); w.w = pk2(st[t][8 * s + 6], st[t][8 * s + 7]);
            pf[2 * t + s] = __builtin_bit_cast(bf16x8, w); }
    bf16_t* orow = p.O() + qrow * DM + h * 256;
#pragma unroll
    for (int dt = 0; dt < 8; ++dt) {
        __syncthreads();
        AT_WRITE();
        if (dt < 7) AT_LOADV(dt + 1);
        __syncthreads();
        f32x16 o;
#pragma unroll
        for (int i = 0; i < 16; ++i) o[i] = 0.f;
        const LAS unsigned char* ap = lds + r * AT_STRIDE + hi * 8;
#pragma unroll
        for (int s16 = 0; s16 < 16; ++s16) { const s16x4 lo = *(const LAS s16x4*)(ap + s16 * 32), hh = *(const LAS s16x4*)(ap + s16 * 32 + 16);
            const bf16x8 a = __builtin_shufflevector(lo, hh, 0, 1, 2, 3, 4, 5, 6, 7); o = MFMA32(a, pf[s16], o); }
#pragma unroll
        for (int g4 = 0; g4 < 4; ++g4) { const int d = dt * 32 + 8 * g4 + 4 * hi;
            u32x2 w; w.x = pk2(o[4 * g4 + 0] * inv, o[4 * g4 + 1] * inv); w.y = pk2(o[4 * g4 + 2] * inv, o[4 * g4 + 3] * inv);
            *(u32x2*)(orow + d) = w; }
    }
    __syncthreads();
#undef AT_LOADK
#undef AT_LOADV
#undef AT_WRITE
}
__device__ __forceinline__ void attn_sample_unit(const Args& p, LAS unsigned char* lds, int unit, int tid) {
    const int lane = tid & 63, wid = tid >> 6;
    const int sb = unit >> 2, h = unit & 3;
    LAS float* S = (LAS float*)lds;
    LAS float* RED = (LAS float*)(lds + 4096);
    const size_t row0 = (size_t)NPT + (size_t)sb * DECS;
    f32x4 qv[4];
#pragma unroll
    for (int i = 0; i < 4; ++i) { const u32x2 w = *(const u32x2*)(p.Q() + (row0 + i) * DM + h * 256 + 4 * lane); qv[i] = (f32x4){bflo(w.x), bfhi(w.x), bflo(w.y), bfhi(w.y)}; }
    const float* kp = p.cache_k() + ((size_t)sb * NMEM * 4 + h) * 256 + 4 * lane;
    const float* vp = p.cache_v() + ((size_t)sb * NMEM * 4 + h) * 256 + 4 * lane;
    const int qi = ((lane & 1) << 1) | ((lane >> 1) & 1);
    f32x4 kv[8], kn[8];
#pragma unroll
    for (int j = 0; j < 8; ++j) kv[j] = *(const f32x4*)(kp + (size_t)(wid * 32 + j) * DM);
#pragma unroll 1
    for (int kk = 0; kk < 4; ++kk) {
        if (kk < 3) {
#pragma unroll
            for (int j = 0; j < 8; ++j) kn[j] = *(const f32x4*)(kp + (size_t)(wid * 32 + (kk + 1) * 8 + j) * DM);
        }
#pragma unroll
        for (int j = 0; j < 8; ++j) {
            float d[4];
#pragma unroll
            for (int i = 0; i < 4; ++i) d[i] = (kv[j][0] * qv[i][0] + kv[j][1] * qv[i][1]) + (kv[j][2] * qv[i][2] + kv[j][3] * qv[i][3]);
            const bool o1 = lane & 1, o2 = lane & 2;
            float k0 = o1 ? d[2] : d[0], k1 = o1 ? d[3] : d[1]; const float s0 = o1 ? d[0] : d[2], s1 = o1 ? d[1] : d[3];
            k0 += __shfl_xor(s0, 1); k1 += __shfl_xor(s1, 1);
            float kq = o2 ? k1 : k0; const float sq = o2 ? k0 : k1;
            kq += __shfl_xor(sq, 2);
            kq += __shfl_xor(kq, 4); kq += __shfl_xor(kq, 8); kq += __shfl_xor(kq, 16); kq += __shfl_xor(kq, 32);
            if (lane < 4) S[(wid * 32 + kk * 8 + j) * 4 + qi] = kq;
        }
#pragma unroll
        for (int j = 0; j < 8; ++j) kv[j] = kn[j];
    }
#pragma unroll
    for (int j = 0; j < 8; ++j) kv[j] = *(const f32x4*)(vp + (size_t)(wid * 32 + j) * DM);
    __syncthreads();
    if (wid < 4) {
        float s[4]; float mx = -3.0e38f;
#pragma unroll
        for (int j = 0; j < 4; ++j) { s[j] = S[(lane + 64 * j) * 4 + wid]; mx = fmaxf(mx, s[j]); }
        mx = wave_max(mx); float sum = 0.f;
#pragma unroll
        for (int j = 0; j < 4; ++j) { s[j] = __expf(s[j] - mx); sum += s[j]; }
        sum = wave_sum(sum); const float inv = 1.0f / sum;
#pragma unroll
        for (int j = 0; j < 4; ++j) S[(lane + 64 * j) * 4 + wid] = s[j] * inv;
    }
    __syncthreads();
    f32x4 acc[4];
#pragma unroll
    for (int i = 0; i < 4; ++i) acc[i] = (f32x4){0.f, 0.f, 0.f, 0.f};
#pragma unroll 1
    for (int kk = 0; kk < 4; ++kk) {
        if (kk < 3) {
#pragma unroll
            for (int j = 0; j < 8; ++j) kn[j] = *(const f32x4*)(vp + (size_t)(wid * 32 + (kk + 1) * 8 + j) * DM);
        }
#pragma unroll
        for (int j = 0; j < 8; ++j) { const f32x4 pv = *(const LAS f32x4*)(S + (wid * 32 + kk * 8 + j) * 4);
#pragma unroll
            for (int i = 0; i < 4; ++i) acc[i] = acc[i] + kv[j] * pv[i]; }
#pragma unroll
        for (int j = 0; j < 8; ++j) kv[j] = kn[j];
    }
#pragma unroll
    for (int i = 0; i < 4; ++i) *(LAS f32x4*)(RED + (wid * 4 + i) * 256 + 4 * lane) = acc[i];
    __syncthreads();
    { const int i = tid >> 7, d = (tid & 127) * 2; float o0 = 0.f, o1 = 0.f;
#pragma unroll
      for (int w = 0; w < 8; ++w) { const f32x2v v = *(const LAS f32x2v*)(RED + (w * 4 + i) * 256 + d); o0 += v.x; o1 += v.y; }
      *(unsigned*)(p.O() + (row0 + i) * DM + h * 256 + d) = pk2(o0, o1); }
    __syncthreads();
}
__device__ __forceinline__ void p5_attention(const Args& p, LAS unsigned char* lds, int G, int bid, int tid) {
    const int vcu = (G % 8 == 0) ? (bid % 8) * (G / 8) + bid / 8 : bid;
    if (vcu & 1) { for (int u = vcu; u < DECB * 4; u += G) attn_sample_unit(p, lds, u, tid); }
    for (int u = vcu; u < NBATCH * 4 * 8; u += G) attn_prompt_unit(p, lds, u, tid);
    if (!(vcu & 1)) { for (int u = vcu; u < DECB * 4; u += G) attn_sample_unit(p, lds, u, tid); }
}

__device__ __forceinline__ void p9_ln3(const Args& p, int G, int bid, int tid) {
    const int lane = tid & 63, gw = bid * 8 + (tid >> 6), NGW = G * 8;
    f32x4 g4[4], b4[4];
#pragma unroll
    for (int j = 0; j < 4; ++j) { g4[j] = ((const f32x4*)p.ln3_g())[lane + 64 * j]; b4[j] = ((const f32x4*)p.ln3_b())[lane + 64 * j]; }
    for (int m = gw; m < MT; m += NGW) {
        const f32x4* xi = (const f32x4*)(p.R1() + (size_t)m * DM) + lane; f32x4* xr = (f32x4*)(p.out() + OY + (size_t)m * DM) + lane;
        f32x4 v[4]; float s = 0.f;
#pragma unroll
        for (int j = 0; j < 4; ++j) { v[j] = xi[64 * j]; s += (v[j].x + v[j].y) + (v[j].z + v[j].w); }
        const float mean = wave_sum(s) * (1.0f / DM); float s2 = 0.f;
#pragma unroll
        for (int j = 0; j < 4; ++j) { v[j] = v[j] - mean; s2 += (v[j].x * v[j].x + v[j].y * v[j].y) + (v[j].z * v[j].z + v[j].w * v[j].w); }
        const float rstd = rsqrtf(wave_sum(s2) * (1.0f / DM) + LN_EPS);
#pragma unroll
        for (int j = 0; j < 4; ++j) xr[64 * j] = v[j] * rstd * g4[j] + b4[j];
    }
}

#define GEMM_PHASE(EpiT, E, A_, B_, M_, N_, K_, c_) do { pg8::Gemm g_{A_, B_, M_, N_, K_}; pg8::StaticOrder S_; S_.init(M_, N_, G, c_); \
        pg8::gemm_phase<EpiT, pg8::StaticOrder, true, true>(lds, g_, S_, E); } while (0)

__global__ void __launch_bounds__(512, 2) fwd_megakernel(Args a) {
    extern __shared__ __attribute__((aligned(16))) unsigned char lds_raw[];
    LAS unsigned char* lds = (LAS unsigned char*)lds_raw;
    cg::grid_group grid = cg::this_grid();
    const int tid = threadIdx.x, bid = blockIdx.x, G = gridDim.x;
    const Args& p = a;
    const int lo = a.ph_lo, hi = a.ph_hi;
#ifndef PH_MASK
#define PH_MASK 0x3ff
#endif
#define IN(k) (((PH_MASK >> (k)) & 1) && lo <= (k) && (k) < hi)
#define SEAM(k) do { if ((k) + 1 < hi) grid.sync(); } while (0)

    if (IN(0)) { p0_prologue(p, lds, G, bid, tid); SEAM(0); }
    if (IN(1)) {
        { EpiIn E{p.b_in(), p.U(), p.P(), p.out()}; GEMM_PHASE(EpiIn, E, p.XB(), p.Win_t(), NPT, DIN, DM, bid); }
        { EpiKV E{p.out(), p.KB(), p.VT()}; const int rot = ((NPT / 256) * (DIN / 256)) % G; GEMM_PHASE(EpiKV, E, p.MB(), p.Wkv_t(), MEMROWS, 2 * DM, DM, (bid + G - rot) % G); }
        { SmallIn E{p.b_in(), p.U(), p.P(), p.out()}; small_gemm_phase(lds, p.XB(), p.Win_t(), DM, DM, DIN / 64, E, G - G / 4, G / 4, bid, tid); }
        SEAM(1);
    }
    if (IN(2)) { p2_mixer(p, G, bid, tid); SEAM(2); }
    if (IN(3)) { { typedef EpiRes<0, false, true, true, false> EpiT; EpiT E{p.XB(), nullptr, nullptr, nullptr, nullptr, p.R1B(), p.ctl() + CF_ST1, nullptr};
          GEMM_PHASE(EpiT, E, p.MIX(), p.Wout_t(), NPT, DM, DM, bid); }
        { SmallRes<0, false, true, true, false> E{p.XB(), nullptr, nullptr, nullptr, nullptr, p.R1B(), p.ctl() + CF_ST1, nullptr}; small_gemm_phase(lds, p.MIX(), p.Wout_t(), DM, DM, DM / 64, E, 0, G, bid, tid); }
        SEAM(3); }
    if (IN(4)) { { typedef EpiFold<0, false> EpiT; EpiT E{p.Q(), DM, p.ctl() + CF_ST1, p.ctl() + CF_C1Q, p.ctl() + CF_C2Q, nullptr, 0.0625f};
          GEMM_PHASE(EpiT, E, p.R1B(), p.Wq_t(), NPT, DM, DM, bid); }
        { SmallFold<0, false> E{p.Q(), DM, p.ctl() + CF_ST1, p.ctl() + CF_C1Q, p.ctl() + CF_C2Q, nullptr, 0.0625f}; small_gemm_phase(lds, p.R1B(), p.Wq_t(), DM, DM, DM / 64, E, 0, G, bid, tid); }
        SEAM(4); }
    if (IN(5)) { p5_attention(p, lds, G, bid, tid); SEAM(5); }
    if (IN(6)) { { typedef EpiRes<1, false, true, true, false> EpiT; EpiT E{p.R1B(), p.ctl() + CF_ST1, p.ln1_g(), p.ln1_b(), nullptr, p.R2B(), p.ctl() + CF_ST2, nullptr};
          GEMM_PHASE(EpiT, E, p.O(), p.Wo_t(), NPT, DM, DM, bid); }
        { SmallRes<1, false, true, true, false> E{p.R1B(), p.ctl() + CF_ST1, p.ln1_g(), p.ln1_b(), nullptr, p.R2B(), p.ctl() + CF_ST2, nullptr}; small_gemm_phase(lds, p.O(), p.Wo_t(), DM, DM, DM / 64, E, 0, G, bid, tid); }
        SEAM(6); }
    if (IN(7)) { { typedef EpiFold<1, true> EpiT; EpiT E{p.H(), DFF, p.ctl() + CF_ST2, p.ctl() + CF_C1H, p.ctl() + CF_C2H, p.b1(), 1.0f};
          GEMM_PHASE(EpiT, E, p.R2B(), p.W1_t(), NPT, DFF, DM, bid); }
        { SmallFold<1, true> E{p.H(), DFF, p.ctl() + CF_ST2, p.ctl() + CF_C1H, p.ctl() + CF_C2H, p.b1(), 1.0f}; small_gemm_phase(lds, p.R2B(), p.W1_t(), DM, DM, DFF / 64, E, 0, G, bid, tid); }
        SEAM(7); }
    if (IN(8)) { { typedef EpiRes<1, true, false, false, true> EpiT; EpiT E{p.R2B(), p.ctl() + CF_ST2, p.ln2_g(), p.ln2_b(), p.R1(), nullptr, nullptr, p.b2()};
          GEMM_PHASE(EpiT, E, p.H(), p.W2_t(), NPT, DM, DFF, bid); }
        { SmallRes<1, true, false, false, true> E{p.R2B(), p.ctl() + CF_ST2, p.ln2_g(), p.ln2_b(), p.R1(), nullptr, nullptr, p.b2()}; small_gemm_phase(lds, p.H(), p.W2_t(), DFF, DFF, DM / 64, E, 0, G, bid, tid); }
        SEAM(8); }
    if (IN(9)) { p9_ln3(p, G, bid, tid); }
#undef IN
#undef SEAM
}

extern "C" void kernel_launch(void* const* d_in, const int* in_sizes, int n_in, void* d_out, int out_size, void* d_ws, size_t ws_size, hipStream_t stream) {
    static int grid = 0;
    if (grid == 0) {
        if (n_in != 30 || (size_t)out_size != OEND || ws_size < WS_END) { fprintf(stderr, "kernel_launch: unexpected problem shape (n_in %d, out %d, ws %zu)\n", n_in, out_size, ws_size); grid = -1; return; }
        int dev = 0, cus = 0, per_cu = 0;
        if (hipGetDevice(&dev) != hipSuccess || hipDeviceGetAttribute(&cus, hipDeviceAttributeMultiprocessorCount, dev) != hipSuccess) { grid = -1; return; }
        if (hipFuncSetAttribute((const void*)fwd_megakernel, hipFuncAttributeMaxDynamicSharedMemorySize, LDS_BYTES) != hipSuccess) { fprintf(stderr, "kernel_launch: hipFuncSetAttribute failed\n"); grid = -1; return; }
        if (hipOccupancyMaxActiveBlocksPerMultiprocessor(&per_cu, (const void*)fwd_megakernel, 512, LDS_BYTES) != hipSuccess || per_cu < 1) { fprintf(stderr, "kernel_launch: occupancy query failed (%d)\n", per_cu); (void)hipGetLastError(); grid = -1; return; }
        grid = cus * per_cu;
    }
    if (grid < 0) return;
    (void)hipMemsetAsync((char*)d_ws + WS_CTL, 0, CTL_ZERO_BYTES, stream);
    Args a{};
    for (int i = 0; i < 30; ++i) a.in[i] = (const float*)d_in[i];
    a.outp = (float*)d_out; a.ws = (unsigned char*)d_ws;
#if MK_PER_PHASE
#ifndef EXTRA_MASK
#define EXTRA_MASK 0
#endif
    for (int ph = 0; ph < NPHASE; ++ph) { a.ph_lo = ph; a.ph_hi = ph + 1; hipLaunchKernelGGL(fwd_megakernel, dim3(grid), dim3(512), LDS_BYTES, stream, a);
        if ((EXTRA_MASK >> ph) & 1) {
            if (ph == 0) (void)hipMemsetAsync((char*)d_ws + WS_CTL, 0, CTL_ZERO_BYTES, stream);
            if (ph == 3) (void)hipMemsetAsync((char*)d_ws + WS_CTL + CF_ST1 * 4, 0, MT * 8, stream);
            if (ph == 6) (void)hipMemsetAsync((char*)d_ws + WS_CTL + CF_ST2 * 4, 0, MT * 8, stream);
            hipLaunchKernelGGL(fwd_megakernel, dim3(grid), dim3(512), LDS_BYTES, stream, a); } }
#else
    a.ph_lo = 0; a.ph_hi = NPHASE;
    void* args[] = {&a};
    hipError_t e = hipLaunchCooperativeKernel((const void*)fwd_megakernel, dim3(grid), dim3(512), args, LDS_BYTES, stream);
    if (e != hipSuccess) fprintf(stderr, "kernel_launch: cooperative launch failed: %s (grid %d)\n", hipGetErrorString(e), grid);
#endif
}
```

```cpp
#include <hip/hip_runtime.h>
#include <hip/hip_cooperative_groups.h>
#include <cstdio>
#include <cstdint>
namespace cg = cooperative_groups;
namespace pg8 {
#define PG8_LAS __attribute__((address_space(3)))
typedef unsigned short bf16_t;
typedef short bf16x8 __attribute__((ext_vector_type(8)));
typedef float f32x4 __attribute__((ext_vector_type(4)));
typedef unsigned u32x4 __attribute__((ext_vector_type(4)));
constexpr int BM = 256, BK = 64, HALF = 128, HTB = HALF * BK * 2  , STAGE_BYTES = 8 * HTB, NXCD = 8, WGM = 8;

__host__ __device__ __forceinline__ int lds_byte(int r, int c) { const int st = (r >> 4) * 2 + (c >> 5), rr = r & 15, cc = c & 31, ob = rr * 64 + cc * 2; return st * 1024 + (ob ^ (((ob >> 9) & 1) << 5)); }
__host__ __device__ __forceinline__ void stage_rc(int b, int& R, int& C) { const int st = b / 1024, sb = b % 1024, swz = sb ^ (((sb >> 9) & 1) << 5); R = (st >> 1) * 16 + swz / 64; C = (st & 1) * 32 + (swz % 64) / 2; }
__host__ __device__ __forceinline__ int perm32(int rho) { const int n = rho >> 4, i = rho & 15; return 8 * (i >> 2) + 4 * n + (i & 3); }

struct Unit { int pm, pn; };
struct Gemm { const bf16_t* A; const bf16_t* Bt; int M, N, K; };

struct StaticOrder {
    int nM, nN, nwg, G, c;
    __host__ __device__ void init(int M, int N, int G_, int c_) { nM = M / BM; nN = N / BM; nwg = nM * nN; G = G_; c = c_; }
    __host__ __device__ bool next(int i, Unit& u) const {
        const long L = (long)i * G + c; if (L >= nwg) return false;
        int wgid = (int)L; { const int q = nwg / NXCD, r = nwg % NXCD, xcd = wgid % NXCD, off = wgid / NXCD; wgid = (xcd < r ? xcd * (q + 1) : r * (q + 1) + (xcd - r) * q) + off; }
        const int nig = WGM * nN, gid = wgid / nig, fm = gid * WGM, gsz = (nM - fm) < WGM ? (nM - fm) : WGM;
        u.pm = fm + ((wgid % nig) % gsz); u.pn = (wgid % nig) / gsz; return true;
    }
    __device__ __forceinline__ void a_ready(const Unit&) const {}
    __device__ __forceinline__ void done(const Unit&) const {}
};

__device__ __forceinline__ unsigned cvt_pk_bf16(float lo, float hi) { unsigned r; asm volatile("v_cvt_pk_bf16_f32 %0, %1, %2" : "=v"(r) : "v"(lo), "v"(hi)); return r; }
typedef float f32x2 __attribute__((ext_vector_type(2)));
template <class Epi, class Sched, bool ALIGN_EPI = false, bool SP2 = false>
__device__ __forceinline__ void gemm_phase(PG8_LAS unsigned char* lds, const Gemm g, const Sched& S, const Epi& E) {
    const int tid = threadIdx.x, wid = __builtin_amdgcn_readfirstlane(tid >> 6), lane = tid & 63, wr = wid >> 2, wc = wid & 3, fr = lane & 15, fq = lane >> 4;
    const int K = g.K, nt = K / BK;
    unsigned voffA[2], voffB[2];
#pragma unroll
    for (int i = 0; i < 2; ++i) { int R, C; stage_rc(tid * 16 + i * 8192, R, C); const int Rb = Epi::PERM ? ((R & ~31) + perm32(R & 31)) : R;
        voffA[i] = (unsigned)(R * K + C) * 2u; voffB[i] = (unsigned)(Rb * K + C) * 2u; }
    const size_t kstep = (size_t)(BK * 2);
    const size_t hstep = (size_t)HALF * K * 2;
    const size_t tstep = 2 * hstep;
    const unsigned ldsw = (unsigned)wid * 1024u;
    const int aoff = lds_byte(wr * 64 + fr, fq * 8), boff = lds_byte(wc * 32 + fr, fq * 8);
#define PG8_SA(b, h) (((b) * 2 + (h)) * HTB)
#define PG8_SB(b, h) ((4 + (b) * 2 + (h)) * HTB)
#define PG8_STAGE(bufoff, gbase, voff) do { _Pragma("unroll") for (int _i = 0; _i < 2; ++_i) \
        __builtin_amdgcn_global_load_lds((const unsigned*)((const char*)(gbase) + (voff)[_i]), (PG8_LAS unsigned*)(lds + (bufoff) + ldsw + _i * 8192), 16, 0, 0); } while (0)
#define PG8_LDA(dst, b, h) do { _Pragma("unroll") for (int m = 0; m < 4; ++m) _Pragma("unroll") for (int k = 0; k < 2; ++k) dst[m][k] = *(const PG8_LAS bf16x8*)(lds + PG8_SA(b, h) + aoff + m * 2048 + k * 1024); } while (0)
#define PG8_LDB(dst, b, h) do { _Pragma("unroll") for (int n = 0; n < 2; ++n) _Pragma("unroll") for (int k = 0; k < 2; ++k) dst[n][k] = *(const PG8_LAS bf16x8*)(lds + PG8_SB(b, h) + boff + n * 2048 + k * 1024); } while (0)
#define PG8_MMA(ai, bj, At, Bt) do { __builtin_amdgcn_s_setprio(1); _Pragma("unroll") for (int m = 0; m < 4; ++m) _Pragma("unroll") for (int n = 0; n < 2; ++n) _Pragma("unroll") for (int k = 0; k < 2; ++k) \
        acc[ai][bj][m][n] = __builtin_amdgcn_mfma_f32_16x16x32_bf16(Bt[n][k], At[m][k], acc[ai][bj][m][n], 0, 0, 0); __builtin_amdgcn_s_setprio(0); } while (0)
#define PG8_WAIT_V(n) asm volatile("s_waitcnt vmcnt(" #n ")" ::: "memory")
#define PG8_WAIT_L(n) asm volatile("s_waitcnt lgkmcnt(" #n ")" ::: "memory")
#define PG8_BAR __builtin_amdgcn_s_barrier()
#define PG8_SCHED __builtin_amdgcn_sched_barrier(0)
    Unit cur, nxt; int ui = 0;
    if (!S.next(0, cur)) return;
    f32x4 acc[2][2][4][2];
#pragma unroll
    for (int a = 0; a < 2; ++a)
#pragma unroll
        for (int b = 0; b < 2; ++b)
#pragma unroll
            for (int m = 0; m < 4; ++m)
#pragma unroll
                for (int n = 0; n < 2; ++n) acc[a][b][m][n] = (f32x4){0.f, 0.f, 0.f, 0.f};
    bf16x8 At[4][2], B0[2][2], B1[2][2];
    const char* cA = (const char*)g.A + (size_t)cur.pm * tstep; const char* cB = (const char*)g.Bt + (size_t)cur.pn * tstep;
    S.a_ready(cur);
    if constexpr (SP2) {
        PG8_STAGE(PG8_SB(0, 0), cB, voffB); PG8_STAGE(PG8_SB(0, 1), cB + hstep, voffB); PG8_STAGE(PG8_SA(0, 0), cA, voffA); PG8_STAGE(PG8_SA(0, 1), cA + hstep, voffA);
        if (wr == 1) PG8_BAR;
        PG8_WAIT_V(2); PG8_BAR;
        PG8_STAGE(PG8_SB(1, 0), cB + kstep, voffB); PG8_STAGE(PG8_SA(1, 0), cA + kstep, voffA); PG8_STAGE(PG8_SB(1, 1), cB + hstep + kstep, voffB);
        PG8_WAIT_V(6); PG8_BAR;
    } else {
        PG8_STAGE(PG8_SB(0, 0), cB, voffB); PG8_STAGE(PG8_SA(0, 0), cA, voffA); PG8_STAGE(PG8_SB(0, 1), cB + hstep, voffB); PG8_STAGE(PG8_SA(0, 1), cA + hstep, voffA);
        if (wr == 1) PG8_BAR;
        PG8_WAIT_V(4); PG8_BAR;
        PG8_STAGE(PG8_SB(1, 0), cB + kstep, voffB); PG8_STAGE(PG8_SA(1, 0), cA + kstep, voffA); PG8_STAGE(PG8_SB(1, 1), cB + hstep + kstep, voffB);
        PG8_WAIT_V(6); PG8_BAR;
    }
    for (;;) {
        const bool has_next = S.next(ui + 1, nxt);
        const char* nA = has_next ? (const char*)g.A + (size_t)nxt.pm * tstep : cA; const char* nB = has_next ? (const char*)g.Bt + (size_t)nxt.pn * tstep : cB;
        for (int t = 0; t < nt; t += 2) {
            const bool last = (t == nt - 2);
            const char* a1 = cA + (size_t)(t + 1) * kstep;
            const char* a2 = last ? nA : cA + (size_t)(t + 2) * kstep; const char* b2 = last ? nB : cB + (size_t)(t + 2) * kstep;
            const char* a3 = a2 + kstep; const char* b3 = b2 + kstep;
            if (last && has_next) S.a_ready(nxt);
            if constexpr (SP2) {
            PG8_LDB(B0, 0, 0); PG8_LDB(B1, 0, 1); PG8_SCHED; PG8_LDA(At, 0, 0); PG8_STAGE(PG8_SA(1, 1), a1 + hstep, voffA);
            PG8_WAIT_V(8); PG8_WAIT_L(0); PG8_BAR; PG8_MMA(0, 0, At, B0); PG8_MMA(0, 1, At, B1); PG8_BAR; PG8_SCHED;
            PG8_LDA(At, 0, 1); PG8_STAGE(PG8_SB(0, 0), b2, voffB); PG8_STAGE(PG8_SB(0, 1), b2 + hstep, voffB); PG8_STAGE(PG8_SA(0, 0), a2, voffA);
            PG8_WAIT_V(8); PG8_WAIT_L(0); PG8_BAR; PG8_MMA(1, 0, At, B0); PG8_MMA(1, 1, At, B1); PG8_BAR; PG8_SCHED;
            PG8_LDB(B0, 1, 0); PG8_LDB(B1, 1, 1); PG8_SCHED; PG8_LDA(At, 1, 0); PG8_STAGE(PG8_SA(0, 1), a2 + hstep, voffA);
            PG8_WAIT_V(8); PG8_WAIT_L(0); PG8_BAR; PG8_MMA(0, 0, At, B0); PG8_MMA(0, 1, At, B1); PG8_BAR; PG8_SCHED;
            PG8_LDA(At, 1, 1); PG8_STAGE(PG8_SB(1, 0), b3, voffB); PG8_STAGE(PG8_SB(1, 1), b3 + hstep, voffB); PG8_STAGE(PG8_SA(1, 0), a3, voffA);
            PG8_WAIT_V(8); PG8_WAIT_L(0); PG8_BAR; PG8_MMA(1, 0, At, B0); PG8_MMA(1, 1, At, B1); PG8_BAR; PG8_SCHED;
            } else {
            PG8_LDB(B0, 0, 0); PG8_SCHED; PG8_LDA(At, 0, 0); PG8_STAGE(PG8_SA(1, 1), a1 + hstep, voffA);
            PG8_WAIT_L(8); PG8_BAR; PG8_WAIT_L(0); PG8_MMA(0, 0, At, B0); PG8_BAR; PG8_SCHED;
            PG8_LDB(B1, 0, 1); PG8_STAGE(PG8_SB(0, 0), b2, voffB);
            PG8_BAR; PG8_WAIT_L(0); PG8_MMA(0, 1, At, B1); PG8_BAR;
            PG8_LDA(At, 0, 1); PG8_STAGE(PG8_SA(0, 0), a2, voffA);
            PG8_BAR; PG8_WAIT_L(0); PG8_MMA(1, 0, At, B0); PG8_BAR; PG8_SCHED;
            PG8_STAGE(PG8_SB(0, 1), b2 + hstep, voffB);
            PG8_WAIT_V(6); PG8_BAR; PG8_MMA(1, 1, At, B1); PG8_BAR;
            PG8_LDB(B0, 1, 0); PG8_SCHED; PG8_LDA(At, 1, 0); PG8_STAGE(PG8_SA(0, 1), a2 + hstep, voffA);
            PG8_WAIT_L(8); PG8_BAR; PG8_WAIT_L(0); PG8_MMA(0, 0, At, B0); PG8_BAR; PG8_SCHED;
            PG8_LDB(B1, 1, 1); PG8_STAGE(PG8_SB(1, 0), b3, voffB);
            PG8_BAR; PG8_WAIT_L(0); PG8_MMA(0, 1, At, B1); PG8_BAR;
            PG8_LDA(At, 1, 1); PG8_STAGE(PG8_SA(1, 0), a3, voffA);
            PG8_BAR; PG8_WAIT_L(0); PG8_MMA(1, 0, At, B0); PG8_BAR; PG8_SCHED;
            PG8_STAGE(PG8_SB(1, 1), b3 + hstep, voffB);
            PG8_WAIT_V(6); PG8_BAR; PG8_MMA(1, 1, At, B1); PG8_BAR;
            }
        }
        if constexpr (ALIGN_EPI) { if (wr == 0) PG8_BAR; }
        if constexpr (!Epi::AFTER_DRAIN) { E(acc, cur, wr, wc, fr, fq); S.done(cur); }
        if (!has_next) break;
#pragma unroll
        for (int a = 0; a < 2; ++a)
#pragma unroll
            for (int b = 0; b < 2; ++b)
#pragma unroll
                for (int m = 0; m < 4; ++m)
#pragma unroll
                    for (int n = 0; n < 2; ++n) acc[a][b][m][n] = (f32x4){0.f, 0.f, 0.f, 0.f};
        cur = nxt; cA = nA; cB = nB; ++ui;
        if constexpr (ALIGN_EPI) { if (wr == 1) PG8_BAR; }
    }
    PG8_WAIT_V(0);
    if constexpr (!ALIGN_EPI) { if (wr == 0) PG8_BAR; }
    PG8_BAR;
    if constexpr (Epi::AFTER_DRAIN) { E.fused(acc, cur, wr, wc, fr, fq, lds, wid, lane); S.done(cur); }
#undef PG8_SA
#undef PG8_SB
#undef PG8_STAGE
#undef PG8_LDA
#undef PG8_LDB
#undef PG8_MMA
#undef PG8_WAIT_V
#undef PG8_WAIT_L
#undef PG8_BAR
#undef PG8_SCHED
}
}

#ifndef MK_PER_PHASE
#define MK_PER_PHASE 0
#endif
#define LAS __attribute__((address_space(3)))
using pg8::bf16_t; using pg8::f32x4; using pg8::u32x4; using pg8::bf16x8; using pg8::Unit;
typedef unsigned u32x2 __attribute__((ext_vector_type(2)));
typedef float f32x2v __attribute__((ext_vector_type(2)));
typedef __bf16 b16x2v __attribute__((ext_vector_type(2)));
typedef float f32x16 __attribute__((ext_vector_type(16)));
typedef short s16x4 __attribute__((ext_vector_type(4)));

constexpr int DM = 1024, SEQ = 2048, NBATCH = 8, NPT = NBATCH * SEQ, DECB = 128, DECS = 4, NST = DECB * DECS, MT = NPT + NST;
constexpr int NMEM = 256, MEMROWS = NBATCH * NMEM, DFF = 4096, DIN = 1536, DC = 512;
constexpr float LN_EPS = 1e-5f, DN_ALPHA = 1.18920711500272f;
constexpr int NPHASE = 10;

constexpr size_t OY = 0, OMK = (size_t)MT * DM, OMV = OMK + (size_t)MEMROWS * DM, OCP = OMV + (size_t)MEMROWS * DM, OCS = OCP + (size_t)NBATCH * 30 * 512,
                 OPP = OCS + (size_t)DECB * 30 * 512, OPS = OPP + (size_t)NBATCH * 15 * 512, OEND = OPS + (size_t)DECB * 15 * 512;
constexpr size_t MiB = 1u << 20;
constexpr size_t WS_CTL = 0, CTL_ZERO_BYTES = 512 * 1024;
constexpr size_t WS_WIN = 2 * MiB, WS_WKV = 5 * MiB, WS_WOUT = 9 * MiB, WS_WQ = 11 * MiB, WS_WO = 13 * MiB, WS_W1 = 15 * MiB, WS_W2 = 23 * MiB;
constexpr size_t WS_KB = 31 * MiB, WS_VT = 35 * MiB, WS_MB = 39 * MiB;
constexpr size_t WS_XB = 44 * MiB, WS_U = 77 * MiB, WS_P = WS_U + (size_t)MT * DC * 2, WS_MIX = 110 * MiB, WS_R1B = 143 * MiB, WS_Q = 176 * MiB, WS_O = 209 * MiB;
constexpr size_t WS_R1 = 242 * MiB, WS_R2 = 308 * MiB, WS_R2B = 374 * MiB, WS_END = 407 * MiB;
constexpr size_t WS_H = 44 * MiB;
static_assert(WS_H + (size_t)MT * DFF * 2 <= WS_Q, "H overlay");
constexpr int CF_ST1 = 0, CF_ST2 = 34816, CF_C1Q = 69632, CF_C2Q = 70656, CF_C1H = 71680, CF_C2H = 75776, CF_END = 79872, CW_BAR = 81920;
static_assert((CW_BAR + 3456) * 4 <= (int)CTL_ZERO_BYTES && CF_END <= CW_BAR && MT * 2 <= CF_ST2, "ctl");

constexpr int LDS_BYTES = 131072 + 4096;

__device__ __forceinline__ unsigned pk2(float lo, float hi) { f32x2v v = {lo, hi}; b16x2v b = __builtin_convertvector(v, b16x2v); return __builtin_bit_cast(unsigned, b); }
__device__ __forceinline__ float bflo(unsigned v) { return __uint_as_float(v << 16); }
__device__ __forceinline__ float bfhi(unsigned v) { return __uint_as_float(v & 0xffff0000u); }
__device__ __forceinline__ float wave_sum(float v) {
#pragma unroll
    for (int o = 1; o < 64; o <<= 1) v += __shfl_xor(v, o);
    return v;
}
__device__ __forceinline__ float wave_max(float v) {
#pragma unroll
    for (int o = 1; o < 64; o <<= 1) v = fmaxf(v, __shfl_xor(v, o));
    return v;
}
__device__ __forceinline__ float fsigmoid(float x) { return __builtin_amdgcn_rcpf(1.0f + __expf(-x)); }

struct Args {
    const float* in[30]; float* outp; unsigned char* ws; int ph_lo, ph_hi;
    __device__ __forceinline__ const float* x_prompt() const { return in[0]; }
    __device__ __forceinline__ const float* x_sample() const { return in[1]; }
    __device__ __forceinline__ const float* mem_prompt() const { return in[2]; }
    __device__ __forceinline__ const float* cache_k() const { return in[3]; }
    __device__ __forceinline__ const float* cache_v() const { return in[4]; }
    __device__ __forceinline__ const float* state_conv() const { return in[5]; }
    __device__ __forceinline__ const float* state_pool() const { return in[6]; }
    __device__ __forceinline__ const float* w_in() const { return in[7]; }
    __device__ __forceinline__ const float* b_in() const { return in[8]; }
    __device__ __forceinline__ const float* conv_w() const { return in[9]; }
    __device__ __forceinline__ const float* conv_b() const { return in[10]; }
    __device__ __forceinline__ const float* gn_g() const { return in[11]; }
    __device__ __forceinline__ const float* gn_b() const { return in[12]; }
    __device__ __forceinline__ const float* pool_w() const { return in[13]; }
    __device__ __forceinline__ const float* pool_scale() const { return in[14]; }
    __device__ __forceinline__ const float* w_out() const { return in[15]; }
    __device__ __forceinline__ const float* ln1_g() const { return in[16]; }
    __device__ __forceinline__ const float* ln1_b() const { return in[17]; }
    __device__ __forceinline__ const float* xq_w() const { return in[18]; }
    __device__ __forceinline__ const float* xk_w() const { return in[19]; }
    __device__ __forceinline__ const float* xv_w() const { return in[20]; }
    __device__ __forceinline__ const float* xo_w() const { return in[21]; }
    __device__ __forceinline__ const float* ln2_g() const { return in[22]; }
    __device__ __forceinline__ const float* ln2_b() const { return in[23]; }
    __device__ __forceinline__ const float* w1() const { return in[24]; }
    __device__ __forceinline__ const float* b1() const { return in[25]; }
    __device__ __forceinline__ const float* w2() const { return in[26]; }
    __device__ __forceinline__ const float* b2() const { return in[27]; }
    __device__ __forceinline__ const float* ln3_g() const { return in[28]; }
    __device__ __forceinline__ const float* ln3_b() const { return in[29]; }
    __device__ __forceinline__ float* out() const { return outp; }
    __device__ __forceinline__ float* ctl() const { return (float*)(ws + WS_CTL); }
    __device__ __forceinline__ bf16_t* Win_t() const { return (bf16_t*)(ws + WS_WIN); }
    __device__ __forceinline__ bf16_t* Wkv_t() const { return (bf16_t*)(ws + WS_WKV); }
    __device__ __forceinline__ bf16_t* Wout_t() const { return (bf16_t*)(ws + WS_WOUT); }
    __device__ __forceinline__ bf16_t* Wq_t() const { return (bf16_t*)(ws + WS_WQ); }
    __device__ __forceinline__ bf16_t* Wo_t() const { return (bf16_t*)(ws + WS_WO); }
    __device__ __forceinline__ bf16_t* W1_t() const { return (bf16_t*)(ws + WS_W1); }
    __device__ __forceinline__ bf16_t* W2_t() const { return (bf16_t*)(ws + WS_W2); }
    __device__ __forceinline__ bf16_t* KB() const { return (bf16_t*)(ws + WS_KB); }
    __device__ __forceinline__ bf16_t* VT() const { return (bf16_t*)(ws + WS_VT); }
    __device__ __forceinline__ bf16_t* MB() const { return (bf16_t*)(ws + WS_MB); }
    __device__ __forceinline__ bf16_t* XB() const { return (bf16_t*)(ws + WS_XB); }
    __device__ __forceinline__ bf16_t* U() const { return (bf16_t*)(ws + WS_U); }
    __device__ __forceinline__ bf16_t* P() const { return (bf16_t*)(ws + WS_P); }
    __device__ __forceinline__ bf16_t* MIX() const { return (bf16_t*)(ws + WS_MIX); }
    __device__ __forceinline__ bf16_t* R1B() const { return (bf16_t*)(ws + WS_R1B); }
    __device__ __forceinline__ bf16_t* Q() const { return (bf16_t*)(ws + WS_Q); }
    __device__ __forceinline__ bf16_t* O() const { return (bf16_t*)(ws + WS_O); }
    __device__ __forceinline__ bf16_t* R2B() const { return (bf16_t*)(ws + WS_R2B); }
    __device__ __forceinline__ bf16_t* H() const { return (bf16_t*)(ws + WS_H); }
    __device__ __forceinline__ float* R1() const { return (float*)(ws + WS_R1); }
    __device__ __forceinline__ float* R2() const { return (float*)(ws + WS_R2); }
};

#define XB_TMO      128
#define XB_XCNT(j)  (256  + 64 * (j))
#define XB_XSUB(j)  (1280 + 64 * (j))
#define XB_XGEN(j)  (2304 + 64 * (j))
#define XB_TOP      3328
#define XB_TOPGEN   3392
#define XCD_BAR_WORDS 3456
#define XB_SPIN_CAP (1u << 18)

__device__ __forceinline__ unsigned xb_ld(unsigned* p)              { return __hip_atomic_load(p, __ATOMIC_RELAXED, __HIP_MEMORY_SCOPE_AGENT); }
__device__ __forceinline__ unsigned xb_add(unsigned* p, unsigned v) { return __hip_atomic_fetch_add(p, v, __ATOMIC_RELAXED, __HIP_MEMORY_SCOPE_AGENT); }
__device__ __forceinline__ unsigned xb_xcc_id() { return (unsigned)__builtin_amdgcn_s_getreg((3 << 11) | 20) & 0xFu; }
#define XB_SPIN(cond, bar) do { unsigned _sp = 0; while (cond) { __builtin_amdgcn_s_sleep(1); \
    if ((++_sp & 255u) == 0u) { if (xb_ld(&(bar)[XB_TMO])) break; if (_sp > XB_SPIN_CAP) { atomicAdd(&(bar)[XB_TMO], 1u); break; } } } } while (0)

struct XcdBarrier {
    unsigned* bar; unsigned x;
    volatile LAS unsigned* st;
};

__device__ __forceinline__ XcdBarrier xcd_barrier_post(unsigned* bar, volatile LAS unsigned* st) {
    XcdBarrier b; b.bar = bar; b.x = xb_xcc_id(); b.st = st;
    if (threadIdx.x == 0) (void)xb_add(&bar[XB_XCNT(b.x)], 1u);
    return b;
}
__device__ __forceinline__ void xcd_barrier_complete(unsigned* bar, unsigned x, unsigned& nloc, unsigned& nx) {
    const unsigned G = gridDim.x * gridDim.y * gridDim.z;
    unsigned sum, cnt, mine, sp = 0u;
    for (;;) {
        sum = 0u; cnt = 0u; mine = 0u;
#pragma unroll
        for (unsigned j = 0; j < 16; ++j) { const unsigned c = xb_ld(&bar[XB_XCNT(j)]); sum += c; cnt += (c > 0u) ? 1u : 0u; mine = (j == x) ? c : mine; }
        if (sum == G) break;
        __builtin_amdgcn_s_sleep(1);
        if ((++sp & 255u) == 0u) { if (xb_ld(&bar[XB_TMO])) break; if (sp > XB_SPIN_CAP) { atomicAdd(&bar[XB_TMO], 1u); break; } }
    }
    nloc = mine > 0u ? mine : 1u; nx = cnt > 0u ? cnt : 1u;
}

__device__ __forceinline__ void xcd_barrier(const XcdBarrier& b) {
    asm volatile("s_waitcnt vmcnt(0)" ::: "memory");
    __syncthreads();
    if (threadIdx.x == 0) {
        unsigned* bar = b.bar;
        __builtin_amdgcn_s_waitcnt(0);
        unsigned nloc = b.st[0], nx = b.st[1];
        if (nloc == 0u) { xcd_barrier_complete(bar, b.x, nloc, nx); b.st[0] = nloc; b.st[1] = nx; }
        const unsigned old = xb_add(&bar[XB_XSUB(b.x)], 1u);
        const unsigned gen = old / nloc;
        if (old + 1u == (gen + 1u) * nloc) {
            __builtin_amdgcn_fence(__ATOMIC_RELEASE, "agent");
            asm volatile("s_waitcnt vmcnt(0)" ::: "memory");
            const unsigned og = xb_add(&bar[XB_TOP], 1u);
            const unsigned tg = og / nx;
            if (og + 1u == (tg + 1u) * nx) xb_add(&bar[XB_TOPGEN], 1u);
            else XB_SPIN(xb_ld(&bar[XB_TOPGEN]) == tg, bar);
            __builtin_amdgcn_fence(__ATOMIC_ACQUIRE, "agent");
            xb_add(&bar[XB_XGEN(b.x)], 1u);
            asm volatile("s_waitcnt vmcnt(0)" ::: "memory");
        } else {
            XB_SPIN(xb_ld(&bar[XB_XGEN(b.x)]) == gen, bar);
            __builtin_amdgcn_fence(__ATOMIC_ACQUIRE, "agent");
            asm volatile("s_waitcnt vmcnt(0)" ::: "memory");
        }
    }
    __syncthreads();
}

__device__ __forceinline__ int win_dest(int n) {
    if (n < 512) return 32 * (n >> 4) + (n & 15);
    if (n < 1024) { const int c = n - 512; return 32 * (c >> 4) + 16 + (c & 15); }
    return n;
}
template <int MODE>
__device__ __forceinline__ void tr_item(const float* __restrict__ W, int N, bf16_t* WT, int ldk, int row_off, LAS float* scr, int kb, int nb, int lane,
                                        const float* g, const float* b, float* c1, float* c2) {
    const int k0 = 64 * kb, n0 = 32 * nb;
    float tv[32];
#pragma unroll
    for (int i = 0; i < 32; ++i) tv[i] = W[(size_t)(k0 + 2 * i + (lane >> 5)) * N + n0 + (lane & 31)];
#pragma unroll
    for (int i = 0; i < 32; ++i) scr[(2 * i + (lane >> 5)) * 33 + (lane & 31)] = tv[i];
    asm volatile("s_waitcnt lgkmcnt(0)" ::: "memory");
    if (MODE == 2) {
        const float* vec = (lane < 32) ? g : b; float s = 0.f;
#pragma unroll 8
        for (int k = 0; k < 64; ++k) s += vec[k0 + k] * scr[k * 33 + (lane & 31)];
        atomicAdd(((lane < 32) ? c1 : c2) + n0 + (lane & 31), s);
    }
    const int c = lane & 7;
    float gs[8];
#pragma unroll
    for (int i = 0; i < 8; ++i) gs[i] = (MODE == 2) ? g[k0 + 8 * c + i] : 1.0f;
#pragma unroll
    for (int j = 0; j < 4; ++j) { const int n = (lane >> 3) + 8 * j; const LAS float* s = scr + (8 * c) * 33 + n;
        u32x4 o; o.x = pk2(s[0 * 33] * gs[0], s[1 * 33] * gs[1]); o.y = pk2(s[2 * 33] * gs[2], s[3 * 33] * gs[3]); o.z = pk2(s[4 * 33] * gs[4], s[5 * 33] * gs[5]); o.w = pk2(s[6 * 33] * gs[6], s[7 * 33] * gs[7]);
        const int dr = (MODE == 1) ? win_dest(n0 + n) : (n0 + n);
        *(u32x4*)(WT + (size_t)(row_off + dr) * ldk + k0 + 8 * c) = o; }
    asm volatile("s_waitcnt lgkmcnt(0)" ::: "memory");
}
__device__ __forceinline__ void poolfold_block(const Args& p, LAS unsigned char* lds, int item, int tid) {
    const int g = item >> 5, nb = item & 31;
    LAS float* PW = (LAS float*)lds;
    LAS float* WO = (LAS float*)(lds + 128 * 132 * 4);
    const float* pw = p.pool_w() + (size_t)g * 16384;
#pragma unroll
    for (int i = 0; i < 8; ++i) { const int idx = tid + 512 * i; *(LAS f32x4*)(PW + (idx >> 5) * 132 + 4 * (idx & 31)) = ((const f32x4*)pw)[idx]; }
#pragma unroll
    for (int i = 0; i < 8; ++i) { const int idx = tid + 512 * i, d = idx >> 5, n = idx & 31; WO[idx] = p.w_out()[(size_t)(512 + 128 * g + d) * DM + 32 * nb + n] * p.pool_scale()[128 * g + d]; }
    __syncthreads();
    const int n = tid & 31, cg = tid >> 5;
    float acc[8];
#pragma unroll
    for (int j = 0; j < 8; ++j) acc[j] = 0.f;
#pragma unroll 4
    for (int d4 = 0; d4 < 32; ++d4) {
        const float w0 = WO[(4 * d4 + 0) * 32 + n], w1 = WO[(4 * d4 + 1) * 32 + n], w2 = WO[(4 * d4 + 2) * 32 + n], w3 = WO[(4 * d4 + 3) * 32 + n];
#pragma unroll
        for (int j = 0; j < 8; ++j) { const f32x4 q = *(const LAS f32x4*)(PW + (cg * 8 + j) * 132 + 4 * d4); acc[j] = fmaf(q[0], w0, fmaf(q[1], w1, fmaf(q[2], w2, fmaf(q[3], w3, acc[j])))); }
    }
    u32x4 o; o.x = pk2(acc[0], acc[1]); o.y = pk2(acc[2], acc[3]); o.z = pk2(acc[4], acc[5]); o.w = pk2(acc[6], acc[7]);
    *(u32x4*)(p.Wout_t() + (size_t)(32 * nb + n) * DM + 512 + 128 * g + cg * 8) = o;
    __syncthreads();
}
__device__ __forceinline__ void row_to_bf16(const float* xrow, bf16_t* orow, int lane) {
    const f32x4* xr = (const f32x4*)xrow + lane; unsigned long long* o8 = (unsigned long long*)orow + lane;
    f32x4 v[4];
#pragma unroll
    for (int j = 0; j < 4; ++j) v[j] = xr[64 * j];
#pragma unroll
    for (int j = 0; j < 4; ++j) o8[64 * j] = (unsigned long long)pk2(v[j].x, v[j].y) | ((unsigned long long)pk2(v[j].z, v[j].w) << 32);
}
__device__ __forceinline__ void p0_prologue(const Args& p, LAS unsigned char* lds, int G, int bid, int tid) {
    const int lane = tid & 63, wave = tid >> 6;
    LAS float* scr = (LAS float*)(lds + wave * 16384);
    const int gw = bid * 8 + wave, NGW = G * 8;
    constexpr int I_IN = 16 * 48, I_K = 16 * 32, I_V = I_K, I_OUT = 8 * 32, I_Q = I_K, I_O = I_K, I_1 = 16 * 128, I_2 = 64 * 32;
    constexpr int NITEMS = I_IN + I_K + I_V + I_OUT + I_Q + I_O + I_1 + I_2;
    for (int it = bid; it < 128; it += G) poolfold_block(p, lds, it, tid);
    for (int it = gw; it < NITEMS; it += NGW) {
        int r = it;
        if (r < I_IN) { tr_item<1>(p.w_in(), DIN, p.Win_t(), DM, 0, scr, r / 48, r % 48, lane, nullptr, nullptr, nullptr, nullptr); continue; } r -= I_IN;
        if (r < I_K) { tr_item<0>(p.xk_w(), DM, p.Wkv_t(), DM, 0, scr, r / 32, r % 32, lane, nullptr, nullptr, nullptr, nullptr); continue; } r -= I_K;
        if (r < I_V) { tr_item<0>(p.xv_w(), DM, p.Wkv_t(), DM, DM, scr, r / 32, r % 32, lane, nullptr, nullptr, nullptr, nullptr); continue; } r -= I_V;
        if (r < I_OUT) { tr_item<0>(p.w_out(), DM, p.Wout_t(), DM, 0, scr, r / 32, r % 32, lane, nullptr, nullptr, nullptr, nullptr); continue; } r -= I_OUT;
        if (r < I_Q) { tr_item<2>(p.xq_w(), DM, p.Wq_t(), DM, 0, scr, r / 32, r % 32, lane, p.ln1_g(), p.ln1_b(), p.ctl() + CF_C1Q, p.ctl() + CF_C2Q); continue; } r -= I_Q;
        if (r < I_O) { tr_item<0>(p.xo_w(), DM, p.Wo_t(), DM, 0, scr, r / 32, r % 32, lane, nullptr, nullptr, nullptr, nullptr); continue; } r -= I_O;
        if (r < I_1) { tr_item<2>(p.w1(), DFF, p.W1_t(), DM, 0, scr, r / 128, r % 128, lane, p.ln2_g(), p.ln2_b(), p.ctl() + CF_C1H, p.ctl() + CF_C2H); continue; } r -= I_1;
        tr_item<0>(p.w2(), DM, p.W2_t(), DFF, 0, scr, r / 32, r % 32, lane, nullptr, nullptr, nullptr, nullptr);
    }
    const int gt = bid * 512 + tid, NT = G * 512;
#define CVT_REGION(src, dst, n4) do { const f32x4* s4_ = (const f32x4*)(src); unsigned long long* d8_ = (unsigned long long*)(dst); \
        _Pragma("unroll 4") for (int i_ = gt; i_ < (n4); i_ += NT) { const f32x4 v_ = s4_[i_]; d8_[i_] = (unsigned long long)pk2(v_.x, v_.y) | ((unsigned long long)pk2(v_.z, v_.w) << 32); } } while (0)
    CVT_REGION(p.x_prompt(), p.XB(), NPT * (DM / 4));
    CVT_REGION(p.x_sample(), p.XB() + (size_t)NPT * DM, NST * (DM / 4));
    CVT_REGION(p.mem_prompt(), p.MB(), MEMROWS * (DM / 4));
#undef CVT_REGION
    for (int i = gt; i < DECB * 3328; i += NT) { const int sb = i / 3328, o = i % 3328; ((f32x4*)(p.out() + OCS + (size_t)sb * 15360))[o] = ((const f32x4*)(p.state_conv() + (size_t)sb * 15360 + 2048))[o]; }
    for (int i = gt; i < DECB * 1408; i += NT) { const int sb = i / 1408, o = i % 1408; ((f32x4*)(p.out() + OPS + (size_t)sb * 7680))[o] = ((const f32x4*)(p.state_pool() + (size_t)sb * 7680 + 2048))[o]; }
}

struct EpiIn {
    static constexpr bool PERM = false, AFTER_DRAIN = false;
    const float* b_in; bf16_t* U; bf16_t* P; float* out;
    __device__ __forceinline__ void operator()(const f32x4 (&acc)[2][2][4][2], const Unit& u, int wr, int wc, int fr, int fq) const {
        if (u.pn < 4) {
#pragma unroll
            for (int bj = 0; bj < 2; ++bj) {
                const int ch = 16 * (8 * u.pn + 4 * bj + wc) + 4 * fq;
                const f32x4 ba = *(const f32x4*)(b_in + ch), bg = *(const f32x4*)(b_in + 512 + ch);
#pragma unroll
                for (int ai = 0; ai < 2; ++ai)
#pragma unroll
                    for (int m = 0; m < 4; ++m) {
                        const int row = u.pm * 256 + ai * 128 + wr * 64 + m * 16 + fr;
                        const f32x4 av = acc[ai][bj][m][0] + ba, gv = acc[ai][bj][m][1] + bg; f32x4 uv;
#pragma unroll
                        for (int e = 0; e < 4; ++e) uv[e] = av[e] * fsigmoid(gv[e]);
                        u32x2 w; w.x = pk2(uv[0], uv[1]); w.y = pk2(uv[2], uv[3]);
                        *(u32x2*)(U + (size_t)row * DC + ch) = w;
                        if (row < NPT) { const int t = row & (SEQ - 1); if (t >= SEQ - 30) *(f32x4*)(out + OCP + ((size_t)(row >> 11) * 30 + (t - (SEQ - 30))) * 512 + ch) = uv; }
                        else { const int s = row - NPT; *(f32x4*)(out + OCS + ((size_t)(s >> 2) * 30 + 26 + (s & 3)) * 512 + ch) = uv; }
                    }
            }
        } else {
#pragma unroll
            for (int bj = 0; bj < 2; ++bj)
#pragma unroll
                for (int n = 0; n < 2; ++n) {
                    const int pc = 256 * (u.pn - 4) + 128 * bj + 32 * wc + 16 * n + 4 * fq;
                    const f32x4 bp = *(const f32x4*)(b_in + 1024 + pc);
#pragma unroll
                    for (int ai = 0; ai < 2; ++ai)
#pragma unroll
                        for (int m = 0; m < 4; ++m) {
                            const int row = u.pm * 256 + ai * 128 + wr * 64 + m * 16 + fr;
                            const f32x4 pv = acc[ai][bj][m][n] + bp;
                            u32x2 w; w.x = pk2(pv[0], pv[1]); w.y = pk2(pv[2], pv[3]);
                            *(u32x2*)(P + (size_t)row * DC + pc) = w;
                            if (row < NPT) { const int t = row & (SEQ - 1); if (t >= SEQ - 15) *(f32x4*)(out + OPP + ((size_t)(row >> 11) * 15 + (t - (SEQ - 15))) * 512 + pc) = pv; }
                            else { const int s = row - NPT; *(f32x4*)(out + OPS + ((size_t)(s >> 2) * 15 + 11 + (s & 3)) * 512 + pc) = pv; }
                        }
                }
        }
    }
};
struct EpiKV {
    static constexpr bool PERM = false, AFTER_DRAIN = false;
    float* out; bf16_t* KB; bf16_t* VT;
    __device__ __forceinline__ void operator()(const f32x4 (&acc)[2][2][4][2], const Unit& u, int wr, int wc, int fr, int fq) const {
#pragma unroll
        for (int bj = 0; bj < 2; ++bj)
#pragma unroll
            for (int n = 0; n < 2; ++n) {
                const int col = u.pn * 256 + 128 * bj + 32 * wc + 16 * n + 4 * fq;
#pragma unroll
                for (int ai = 0; ai < 2; ++ai)
#pragma unroll
                    for (int m = 0; m < 4; ++m) {
                        const int row = u.pm * 256 + ai * 128 + wr * 64 + m * 16 + fr;
                        const f32x4 v = acc[ai][bj][m][n];
                        if (u.pn < 4) {
                            *(f32x4*)(out + OMK + (size_t)row * DM + col) = v;
                            u32x2 w; w.x = pk2(v[0], v[1]); w.y = pk2(v[2], v[3]);
                            *(u32x2*)(KB + (size_t)row * DM + col) = w;
                        } else {
                            const int c = col - DM;
                            *(f32x4*)(out + OMV + (size_t)row * DM + c) = v;
                            const int b = row >> 8, key = row & 255, h = c >> 8, d = c & 255;
                            bf16_t* vt = VT + ((size_t)((b * 4 + h) * 256 + d)) * 256 + key;
                            const unsigned w0 = pk2(v[0], v[1]), w1 = pk2(v[2], v[3]);
                            vt[0] = (bf16_t)(w0 & 0xffffu); vt[256] = (bf16_t)(w0 >> 16); vt[512] = (bf16_t)(w1 & 0xffffu); vt[768] = (bf16_t)(w1 >> 16);
                        }
                    }
            }
    }
};
template <int MODE, bool HAS_F32, bool HAS_BF, bool HAS_STATS, bool HAS_BIAS>
struct EpiRes {
    static constexpr bool PERM = false, AFTER_DRAIN = false;
    const bf16_t* xb; const float* stp; const float* g; const float* b;
    float* Rout; bf16_t* Rb; float* st; const float* bias;
    __device__ __forceinline__ void operator()(const f32x4 (&acc)[2][2][4][2], const Unit& u, int wr, int wc, int fr, int fq) const {
        const int colb = u.pn * 256 + 32 * wc + 4 * fq;
        f32x4 g4[2][2], b4[2][2], bi4[2][2];
#pragma unroll
        for (int bj = 0; bj < 2; ++bj)
#pragma unroll
            for (int n = 0; n < 2; ++n) { const int col = colb + 128 * bj + 16 * n;
                if (MODE == 1) { g4[bj][n] = *(const f32x4*)(g + col); b4[bj][n] = *(const f32x4*)(b + col); }
                if (HAS_BIAS) bi4[bj][n] = *(const f32x4*)(bias + col); }
#pragma unroll
        for (int ai = 0; ai < 2; ++ai)
#pragma unroll
            for (int m = 0; m < 4; ++m) {
                const int row = u.pm * 256 + ai * 128 + wr * 64 + m * 16 + fr;
                float mu = 0.f, rs = 1.f;
                if (MODE == 1) { const f32x2v s2 = *(const f32x2v*)(stp + 2 * row); mu = s2.x * (1.0f / DM); rs = rsqrtf(fmaxf(s2.y * (1.0f / DM) - mu * mu, 0.f) + LN_EPS); }
                const bf16_t* xrow = xb + (size_t)row * DM;
                float sum = 0.f, sq = 0.f;
#pragma unroll
                for (int bj = 0; bj < 2; ++bj)
#pragma unroll
                    for (int n = 0; n < 2; ++n) { const int col = colb + 128 * bj + 16 * n;
                        const u32x2 xw = *(const u32x2*)(xrow + col); f32x4 xv = {bflo(xw.x), bfhi(xw.x), bflo(xw.y), bfhi(xw.y)};
                        if (MODE == 1) xv = (xv - mu) * rs * g4[bj][n] + b4[bj][n];
                        f32x4 r = xv * DN_ALPHA + acc[ai][bj][m][n];
                        if (HAS_BIAS) r = r + bi4[bj][n];
                        if (HAS_F32) *(f32x4*)(Rout + (size_t)row * DM + col) = r;
                        if (HAS_BF) { u32x2 w; w.x = pk2(r[0], r[1]); w.y = pk2(r[2], r[3]); *(u32x2*)(Rb + (size_t)row * DM + col) = w; }
                        if (HAS_STATS) { sum += (r[0] + r[1]) + (r[2] + r[3]); sq += (r[0] * r[0] + r[1] * r[1]) + (r[2] * r[2] + r[3] * r[3]); }
                    }
                if (HAS_STATS) {
                    sum += __shfl_xor(sum, 16); sum += __shfl_xor(sum, 32); sq += __shfl_xor(sq, 16); sq += __shfl_xor(sq, 32);
                    if (fq == 0) { atomicAdd(st + 2 * row, sum); atomicAdd(st + 2 * row + 1, sq); }
                }
            }
    }
};
template <int ACT  , bool HAS_BIAS>
struct EpiFold {
    static constexpr bool PERM = true, AFTER_DRAIN = false;
    bf16_t* O; int ldc; const float* stp; const float* c1; const float* c2; const float* bias; float scale;
    __device__ __forceinline__ void operator()(const f32x4 (&acc)[2][2][4][2], const Unit& u, int wr, int wc, int fr, int fq) const {
        const int colb = u.pn * 256 + 32 * wc + 8 * fq;
        f32x4 c1v[2][2], c2v[2][2];
#pragma unroll
        for (int bj = 0; bj < 2; ++bj)
#pragma unroll
            for (int n = 0; n < 2; ++n) { const int col = colb + 128 * bj + 4 * n; c1v[bj][n] = *(const f32x4*)(c1 + col); c2v[bj][n] = *(const f32x4*)(c2 + col);
                if (HAS_BIAS) c2v[bj][n] = c2v[bj][n] + *(const f32x4*)(bias + col); }
#pragma unroll
        for (int ai = 0; ai < 2; ++ai)
#pragma unroll
            for (int m = 0; m < 4; ++m) {
                const int row = u.pm * 256 + ai * 128 + wr * 64 + m * 16 + fr;
                const f32x2v s2 = *(const f32x2v*)(stp + 2 * row); const float mu = s2.x * (1.0f / DM); const float rs = rsqrtf(fmaxf(s2.y * (1.0f / DM) - mu * mu, 0.f) + LN_EPS);
#pragma unroll
                for (int bj = 0; bj < 2; ++bj) {
                    f32x4 v0 = (acc[ai][bj][m][0] - c1v[bj][0] * mu) * rs + c2v[bj][0], v1 = (acc[ai][bj][m][1] - c1v[bj][1] * mu) * rs + c2v[bj][1];
                    if (ACT == 1) {
#pragma unroll
                        for (int e = 0; e < 4; ++e) { const float a = fmaxf(v0[e], 0.f), c = fmaxf(v1[e], 0.f); v0[e] = a * a; v1[e] = c * c; }
                    }
                    v0 = v0 * scale; v1 = v1 * scale;
                    u32x4 w; w.x = pk2(v0[0], v0[1]); w.y = pk2(v0[2], v0[3]); w.z = pk2(v1[0], v1[1]); w.w = pk2(v1[2], v1[3]);
                    *(u32x4*)(O + (size_t)row * ldc + colb + 128 * bj) = w;
                }
            }
    }
};

constexpr int SG_STRIDE = 528, SG_BOFF = 64 * SG_STRIDE;
template <class Epi>
__device__ __forceinline__ void small_gemm_phase(LAS unsigned char* lds, const bf16_t* A, const bf16_t* Bt, int K, int ld, int ncol64, const Epi& E, int first, int nblk, int bid, int tid) {
    const int lane = tid & 63, wid = tid >> 6, fr = lane & 15, fq = lane >> 4, mt = wid >> 1, nh = wid & 1;
    const int ub = bid - first; if (ub < 0 || ub >= nblk) return;
    const int nch = K >> 8;
    for (int u = ub; u < 8 * ncol64; u += nblk) {
        const int rt = u & 7, ct = u >> 3;
        const int row0 = NPT + 64 * rt, col0 = 64 * ct;
        u32x4 ra[4], rb[4];
#define SG_LOAD(kc) do { _Pragma("unroll") for (int i_ = 0; i_ < 4; ++i_) { const int idx_ = tid + 512 * i_; \
            ra[i_] = *(const u32x4*)(A + (size_t)(row0 + (idx_ >> 5)) * ld + (kc) * 256 + (idx_ & 31) * 8); rb[i_] = *(const u32x4*)(Bt + (size_t)(col0 + (idx_ >> 5)) * ld + (kc) * 256 + (idx_ & 31) * 8); } } while (0)
        SG_LOAD(0);
        f32x4 acc0 = {0.f, 0.f, 0.f, 0.f}, acc1 = {0.f, 0.f, 0.f, 0.f};
        const LAS unsigned char* apl = lds + (16 * mt + fr) * SG_STRIDE + 16 * fq;
        const LAS unsigned char* bpl = lds + SG_BOFF + (32 * nh + fr) * SG_STRIDE + 16 * fq;
#pragma unroll 1
        for (int kc = 0; kc < nch; ++kc) {
            __syncthreads();
#pragma unroll
            for (int i = 0; i < 4; ++i) { const int idx = tid + 512 * i; *(LAS u32x4*)(lds + (idx >> 5) * SG_STRIDE + (idx & 31) * 16) = ra[i]; *(LAS u32x4*)(lds + SG_BOFF + (idx >> 5) * SG_STRIDE + (idx & 31) * 16) = rb[i]; }
            if (kc + 1 < nch) SG_LOAD(kc + 1);
            __syncthreads();
#pragma unroll
            for (int s8 = 0; s8 < 8; ++s8) {
                const bf16x8 a = *(const LAS bf16x8*)(apl + s8 * 64), b0 = *(const LAS bf16x8*)(bpl + s8 * 64), b1 = *(const LAS bf16x8*)(bpl + 16 * SG_STRIDE + s8 * 64);
                acc0 = __builtin_amdgcn_mfma_f32_16x16x32_bf16(b0, a, acc0, 0, 0, 0);
                acc1 = __builtin_amdgcn_mfma_f32_16x16x32_bf16(b1, a, acc1, 0, 0, 0);
            }
        }
#undef SG_LOAD
        E(row0 + 16 * mt + fr, col0 + 32 * nh, fq, acc0, acc1);
    }
    __syncthreads();
}
struct SmallIn {
    const float* b_in; bf16_t* U; bf16_t* P; float* out;
    __device__ __forceinline__ void operator()(int row, int colb, int fq, f32x4 acc0, f32x4 acc1) const {
        const int s = row - NPT;
        if (colb < 1024) {
            const int ch = 16 * (colb >> 5) + 4 * fq;
            const f32x4 av = acc0 + *(const f32x4*)(b_in + ch), gv = acc1 + *(const f32x4*)(b_in + 512 + ch); f32x4 uv;
#pragma unroll
            for (int e = 0; e < 4; ++e) uv[e] = av[e] * fsigmoid(gv[e]);
            u32x2 w; w.x = pk2(uv[0], uv[1]); w.y = pk2(uv[2], uv[3]);
            *(u32x2*)(U + (size_t)row * DC + ch) = w;
            *(f32x4*)(out + OCS + ((size_t)(s >> 2) * 30 + 26 + (s & 3)) * 512 + ch) = uv;
        } else {
#pragma unroll
            for (int t = 0; t < 2; ++t) { const int pc = colb - 1024 + 16 * t + 4 * fq; const f32x4 pv = (t ? acc1 : acc0) + *(const f32x4*)(b_in + 1024 + pc);
                u32x2 w; w.x = pk2(pv[0], pv[1]); w.y = pk2(pv[2], pv[3]);
                *(u32x2*)(P + (size_t)row * DC + pc) = w;
                *(f32x4*)(out + OPS + ((size_t)(s >> 2) * 15 + 11 + (s & 3)) * 512 + pc) = pv; }
        }
    }
};
template <int MODE, bool HAS_F32, bool HAS_BF, bool HAS_STATS, bool HAS_BIAS>
struct SmallRes {
    const bf16_t* xb; const float* stp; const float* g; const float* b;
    float* Rout; bf16_t* Rb; float* st; const float* bias;
    __device__ __forceinline__ void operator()(int row, int colb, int fq, f32x4 acc0, f32x4 acc1) const {
        float mu = 0.f, rs = 1.f;
        if (MODE == 1) { const f32x2v s2 = *(const f32x2v*)(stp + 2 * row); mu = s2.x * (1.0f / DM); rs = rsqrtf(fmaxf(s2.y * (1.0f / DM) - mu * mu, 0.f) + LN_EPS); }
        const bf16_t* xrow = xb + (size_t)row * DM;
        float sum = 0.f, sq = 0.f;
#pragma unroll
        for (int t = 0; t < 2; ++t) { const int col = colb + 16 * t + 4 * fq;
            const u32x2 xw = *(const u32x2*)(xrow + col); f32x4 xv = {bflo(xw.x), bfhi(xw.x), bflo(xw.y), bfhi(xw.y)};
            if (MODE == 1) xv = (xv - mu) * rs * *(const f32x4*)(g + col) + *(const f32x4*)(b + col);
            f32x4 r = xv * DN_ALPHA + (t ? acc1 : acc0);
            if (HAS_BIAS) r = r + *(const f32x4*)(bias + col);
            if (HAS_F32) *(f32x4*)(Rout + (size_t)row * DM + col) = r;
            if (HAS_BF) { u32x2 w; w.x = pk2(r[0], r[1]); w.y = pk2(r[2], r[3]); *(u32x2*)(Rb + (size_t)row * DM + col) = w; }
            if (HAS_STATS) { sum += (r[0] + r[1]) + (r[2] + r[3]); sq += (r[0] * r[0] + r[1] * r[1]) + (r[2] * r[2] + r[3] * r[3]); } }
        if (HAS_STATS) {
            sum += __shfl_xor(sum, 16); sum += __shfl_xor(sum, 32); sq += __shfl_xor(sq, 16); sq += __shfl_xor(sq, 32);
            if (fq == 0) { atomicAdd(st + 2 * row, sum); atomicAdd(st + 2 * row + 1, sq); }
        }
    }
};
template <int ACT, bool HAS_BIAS>
struct SmallFold {
    bf16_t* O; int ldc; const float* stp; const float* c1; const float* c2; const float* bias; float scale;
    __device__ __forceinline__ void operator()(int row, int colb, int fq, f32x4 acc0, f32x4 acc1) const {
        const f32x2v s2 = *(const f32x2v*)(stp + 2 * row); const float mu = s2.x * (1.0f / DM); const float rs = rsqrtf(fmaxf(s2.y * (1.0f / DM) - mu * mu, 0.f) + LN_EPS);
#pragma unroll
        for (int t = 0; t < 2; ++t) { const int col = colb + 16 * t + 4 * fq;
            f32x4 c2v = *(const f32x4*)(c2 + col); if (HAS_BIAS) c2v = c2v + *(const f32x4*)(bias + col);
            f32x4 v = ((t ? acc1 : acc0) - *(const f32x4*)(c1 + col) * mu) * rs + c2v;
            if (ACT == 1) {
#pragma unroll
                for (int e = 0; e < 4; ++e) { const float a = fmaxf(v[e], 0.f); v[e] = a * a; }
            }
            v = v * scale;
            u32x2 w; w.x = pk2(v[0], v[1]); w.y = pk2(v[2], v[3]);
            *(u32x2*)(O + (size_t)row * ldc + col) = w; }
    }
};

__device__ __forceinline__ void gn_swish_store(float v0, float v1, f32x2v gg, f32x2v gb, unsigned* dst) {
    float s = v0 + v1;
#pragma unroll
    for (int o = 1; o < 32; o <<= 1) s += __shfl_xor(s, o);
    const float mean = s * (1.0f / 64.0f); const float d0 = v0 - mean, d1 = v1 - mean;
    float q = d0 * d0 + d1 * d1;
#pragma unroll
    for (int o = 1; o < 32; o <<= 1) q += __shfl_xor(q, o);
    const float rstd = rsqrtf(q * (1.0f / 64.0f) + LN_EPS);
    float y0 = d0 * rstd * gg.x + gb.x, y1 = d1 * rstd * gg.y + gb.y;
    y0 = y0 * fsigmoid(y0); y1 = y1 * fsigmoid(y1);
    *dst = pk2(y0, y1);
}
__device__ __forceinline__ void mixer_prompt_run(const Args& p, int run, int c2) {
    const int b = run >> 7, t0 = (run & 127) * 16;
    const unsigned* U32 = (const unsigned*)p.U(); const unsigned* P32 = (const unsigned*)p.P(); unsigned* M32 = (unsigned*)p.MIX();
    const size_t rowb = (size_t)b * SEQ;
    {
        unsigned pin[31];
#pragma unroll
        for (int i = 0; i < 31; ++i) { const int t = t0 - 15 + i; const unsigned v = P32[(rowb + (t >= 0 ? t : 0)) * 256 + c2]; pin[i] = (t >= 0) ? v : 0u; }
        const int w = 2 << (c2 >> 6);
#pragma unroll
        for (int t = 0; t < 16; ++t) { float s0 = 0.f, s1 = 0.f;
#pragma unroll
            for (int i = 0; i < 16; ++i) { const unsigned v = (i < w) ? pin[15 + t - i] : 0u; s0 += bflo(v); s1 += bfhi(v); }
            const float cnt = (float)min(t0 + t + 1, w); const unsigned cur = pin[15 + t];
            M32[(rowb + t0 + t) * 512 + 256 + c2] = pk2(s0 / cnt - bflo(cur), s1 / cnt - bfhi(cur)); }
    }
    asm volatile("" ::: "memory");
    {
        float w0[31], w1[31];
#pragma unroll
        for (int j = 0; j < 31; ++j) { const f32x2v w = *(const f32x2v*)(p.conv_w() + j * 512 + 2 * c2); w0[j] = w.x; w1[j] = w.y; }
        const f32x2v cb = *(const f32x2v*)(p.conv_b() + 2 * c2);
        const f32x2v gg = *(const f32x2v*)(p.gn_g() + 2 * c2), gb = *(const f32x2v*)(p.gn_b() + 2 * c2);
#pragma unroll 1
        for (int hh = 0; hh < 2; ++hh) {
            float a0[8], a1[8];
#pragma unroll
            for (int t = 0; t < 8; ++t) { a0[t] = cb.x; a1[t] = cb.y; }
#pragma unroll
            for (int i = 0; i < 38; ++i) {
                const int ti = t0 + 8 * hh - 30 + i; unsigned v = U32[(rowb + (ti >= 0 ? ti : 0)) * 256 + c2]; v = (ti >= 0) ? v : 0u; const float x0 = bflo(v), x1 = bfhi(v);
#pragma unroll
                for (int t = 0; t < 8; ++t) { const int j = i - t; if (j >= 0 && j <= 30) { a0[t] = fmaf(w0[j], x0, a0[t]); a1[t] = fmaf(w1[j], x1, a1[t]); } }
                if ((i & 7) == 7) asm volatile("" ::: "memory");
            }
#pragma unroll
            for (int t = 0; t < 8; ++t) gn_swish_store(a0[t], a1[t], gg, gb, M32 + (rowb + t0 + 8 * hh + t) * 512 + c2);
            asm volatile("" ::: "memory");
        }
    }
}
__device__ __forceinline__ void mixer_sample_run(const Args& p, int sb, int c2) {
    const unsigned* U32 = (const unsigned*)p.U(); const unsigned* P32 = (const unsigned*)p.P(); unsigned* M32 = (unsigned*)p.MIX();
    const size_t rowb = (size_t)NPT + (size_t)sb * DECS;
    {
        float w0[31], w1[31];
#pragma unroll
        for (int j = 0; j < 31; ++j) { const f32x2v w = *(const f32x2v*)(p.conv_w() + j * 512 + 2 * c2); w0[j] = w.x; w1[j] = w.y; }
        const f32x2v cb = *(const f32x2v*)(p.conv_b() + 2 * c2);
        float a0[4], a1[4];
#pragma unroll
        for (int t = 0; t < 4; ++t) { a0[t] = cb.x; a1[t] = cb.y; }
#pragma unroll
        for (int i = 0; i < 34; ++i) {
            float x0, x1;
            if (i < 30) { const f32x2v v = *(const f32x2v*)(p.state_conv() + ((size_t)sb * 30 + i) * 512 + 2 * c2); x0 = v.x; x1 = v.y; }
            else { const unsigned v = U32[(rowb + (i - 30)) * 256 + c2]; x0 = bflo(v); x1 = bfhi(v); }
#pragma unroll
            for (int t = 0; t < 4; ++t) { const int j = i - t; if (j >= 0 && j <= 30) { a0[t] = fmaf(w0[j], x0, a0[t]); a1[t] = fmaf(w1[j], x1, a1[t]); } }
        }
        const f32x2v gg = *(const f32x2v*)(p.gn_g() + 2 * c2), gb = *(const f32x2v*)(p.gn_b() + 2 * c2);
#pragma unroll
        for (int t = 0; t < 4; ++t) gn_swish_store(a0[t], a1[t], gg, gb, M32 + (rowb + t) * 512 + c2);
    }
    {
        float q0[19], q1[19];
#pragma unroll
        for (int i = 0; i < 15; ++i) { const f32x2v v = *(const f32x2v*)(p.state_pool() + ((size_t)sb * 15 + i) * 512 + 2 * c2); q0[i] = v.x; q1[i] = v.y; }
#pragma unroll
        for (int t = 0; t < 4; ++t) { const unsigned v = P32[(rowb + t) * 256 + c2]; q0[15 + t] = bflo(v); q1[15 + t] = bfhi(v); }
        const int w = 2 << (c2 >> 6); const float cnt = (float)w;
#pragma unroll
        for (int t = 0; t < 4; ++t) { float s0 = 0.f, s1 = 0.f;
#pragma unroll
            for (int i = 0; i < 16; ++i) { if (i < w) { s0 += q0[15 + t - i]; s1 += q1[15 + t - i]; } }
            M32[(rowb + t) * 512 + 256 + c2] = pk2(s0 / cnt - q0[15 + t], s1 / cnt - q1[15 + t]); }
    }
}
__device__ __forceinline__ void p2_mixer(const Args& p, int G, int bid, int tid) {
    const int half = __builtin_amdgcn_readfirstlane(tid >> 8), c2 = tid & 255;
    for (int it = bid; it < 512 + 64; it += G) {
        if (it < 512) mixer_prompt_run(p, 2 * it + half, c2);
        else mixer_sample_run(p, 2 * (it - 512) + half, c2);
    }
}

#define MFMA32(a, b, c) __builtin_amdgcn_mfma_f32_32x32x16_bf16((a), (b), (c), 0, 0, 0)
constexpr int AT_STRIDE = 528;
__device__ __forceinline__ void attn_prompt_unit(const Args& p, LAS unsigned char* lds, int unit, int tid) {
    const int lane = tid & 63, wid = tid >> 6, r = lane & 31, hi = lane >> 5;
    const int b = unit >> 5, h = (unit >> 3) & 3, qb = unit & 7;
    const size_t qrow = (size_t)b * SEQ + qb * 256 + wid * 32 + r;
    bf16x8 qf[8];
    LAS bf16x8* qlds = (LAS bf16x8*)(lds + 17408 + wid * 8192) + lane;
    { const bf16_t* qp = p.Q() + qrow * DM + h * 256 + 8 * hi;
#pragma unroll
      for (int ks = 0; ks < 8; ++ks) qf[ks] = *(const bf16x8*)(qp + ks * 16);
#pragma unroll
      for (int ks = 0; ks < 8; ++ks) qlds[ks * 64] = *(const bf16x8*)(qp + (8 + ks) * 16); }
    const bf16_t* kbase = p.KB() + (size_t)(b * NMEM) * DM + h * 256;
    const bf16_t* vbase = p.VT() + (size_t)((b * 4 + h) * 256) * 256;
    u32x4 stg[2];
    f32x16 st[8];
#pragma unroll
    for (int t = 0; t < 8; ++t)
#pragma unroll
        for (int i = 0; i < 16; ++i) st[t][i] = 0.f;
#define AT_LOADK(kt) do { _Pragma("unroll") for (int i_ = 0; i_ < 2; ++i_) { const int idx_ = tid + 512 * i_; stg[i_] = *(const u32x4*)(kbase + (size_t)((kt) * 32 + (idx_ >> 5)) * DM + (idx_ & 31) * 8); } } while (0)
#define AT_LOADV(dt) do { _Pragma("unroll") for (int i_ = 0; i_ < 2; ++i_) { const int idx_ = tid + 512 * i_; stg[i_] = *(const u32x4*)(vbase + (size_t)((dt) * 32 + (idx_ >> 5)) * 256 + (idx_ & 31) * 8); } } while (0)
#define AT_WRITE() do { _Pragma("unroll") for (int i_ = 0; i_ < 2; ++i_) { const int idx_ = tid + 512 * i_; *(LAS u32x4*)(lds + (idx_ >> 5) * AT_STRIDE + (idx_ & 31) * 16) = stg[i_]; } } while (0)
    AT_LOADK(0);
#pragma unroll
    for (int kt = 0; kt < 8; ++kt) {
        __syncthreads();
        AT_WRITE();
        if (kt < 7) AT_LOADK(kt + 1); else AT_LOADV(0);
        __syncthreads();
        const LAS unsigned char* ap = lds + r * AT_STRIDE + hi * 16;
#pragma unroll
        for (int ks = 0; ks < 8; ++ks) { const bf16x8 a = *(const LAS bf16x8*)(ap + ks * 32); st[kt] = MFMA32(a, qf[ks], st[kt]); }
#pragma unroll
        for (int ks = 0; ks < 8; ++ks) { const bf16x8 a = *(const LAS bf16x8*)(ap + (8 + ks) * 32); const bf16x8 qb8 = qlds[ks * 64]; st[kt] = MFMA32(a, qb8, st[kt]); }
    }
    float mx = -3.0e38f;
#pragma unroll
    for (int t = 0; t < 8; ++t)
#pragma unroll
        for (int i = 0; i < 16; ++i) mx = fmaxf(mx, st[t][i]);
    mx = fmaxf(mx, __shfl_xor(mx, 32));
    float sum = 0.f;
#pragma unroll
    for (int t = 0; t < 8; ++t)
#pragma unroll
        for (int i = 0; i < 16; ++i) { const float e = __expf(st[t][i] - mx); st[t][i] = e; sum += e; }
    sum += __shfl_xor(sum, 32);
    const float inv = 1.0f / sum;
    bf16x8 pf[16];
#pragma unroll
    for (int t = 0; t < 8; ++t)
#pragma unroll
        for (int s = 0; s < 2; ++s) { u32x4 w; w.x = pk2(st[t][8 * s + 0], st[t][8 * s + 1]); w.y = pk2(st[t][8 * s + 2], st[t][8 * s + 3]); w.z = pk2(st[t][8 * s + 4], st[t][8 * s + 5]); w.w = pk2(st[t][8 * s + 6], st[t][8 * s + 7]);
            pf[2 * t + s] = __builtin_bit_cast(bf16x8, w); }
    bf16_t* orow = p.O() + qrow * DM + h * 256;
#pragma unroll
    for (int dt = 0; dt < 8; ++dt) {
        __syncthreads();
        AT_WRITE();
        if (dt < 7) AT_LOADV(dt + 1);
        __syncthreads();
        f32x16 o;
#pragma unroll
        for (int i = 0; i < 16; ++i) o[i] = 0.f;
        const LAS unsigned char* ap = lds + r * AT_STRIDE + hi * 8;
#pragma unroll
        for (int s16 = 0; s16 < 16; ++s16) { const s16x4 lo = *(const LAS s16x4*)(ap + s16 * 32), hh = *(const LAS s16x4*)(ap + s16 * 32 + 16);
            const bf16x8 a = __builtin_shufflevector(lo, hh, 0, 1, 2, 3, 4, 5, 6, 7); o = MFMA32(a, pf[s16], o); }
#pragma unroll
        for (int g4 = 0; g4 < 4; ++g4) { const int d = dt * 32 + 8 * g4 + 4 * hi;
            u32x2 w; w.x = pk2(o[4 * g4 + 0] * inv, o[4 * g4 + 1] * inv); w.y = pk2(o[4 * g4 + 2] * inv, o[4 * g4 + 3] * inv);
            *(u32x2*)(orow + d) = w; }
    }
    __syncthreads();
#undef AT_LOADK
#undef AT_LOADV
#undef AT_WRITE
}
__device__ __forceinline__ void attn_sample_unit(const Args& p, LAS unsigned char* lds, int unit, int tid) {
    const int lane = tid & 63, wid = tid >> 6;
    const int sb = unit >> 2, h = unit & 3;
    LAS float* S = (LAS float*)lds;
    LAS float* RED = (LAS float*)(lds + 4096);
    const size_t row0 = (size_t)NPT + (size_t)sb * DECS;
    f32x4 qv[4];
#pragma unroll
    for (int i = 0; i < 4; ++i) { const u32x2 w = *(const u32x2*)(p.Q() + (row0 + i) * DM + h * 256 + 4 * lane); qv[i] = (f32x4){bflo(w.x), bfhi(w.x), bflo(w.y), bfhi(w.y)}; }
    const float* kp = p.cache_k() + ((size_t)sb * NMEM * 4 + h) * 256 + 4 * lane;
    const float* vp = p.cache_v() + ((size_t)sb * NMEM * 4 + h) * 256 + 4 * lane;
    const int qi = ((lane & 1) << 1) | ((lane >> 1) & 1);
    f32x4 kv[8], kn[8];
#pragma unroll
    for (int j = 0; j < 8; ++j) kv[j] = *(const f32x4*)(kp + (size_t)(wid * 32 + j) * DM);
#pragma unroll 1
    for (int kk = 0; kk < 4; ++kk) {
        if (kk < 3) {
#pragma unroll
            for (int j = 0; j < 8; ++j) kn[j] = *(const f32x4*)(kp + (size_t)(wid * 32 + (kk + 1) * 8 + j) * DM);
        }
#pragma unroll
        for (int j = 0; j < 8; ++j) {
            float d[4];
#pragma unroll
            for (int i = 0; i < 4; ++i) d[i] = (kv[j][0] * qv[i][0] + kv[j][1] * qv[i][1]) + (kv[j][2] * qv[i][2] + kv[j][3] * qv[i][3]);
            const bool o1 = lane & 1, o2 = lane & 2;
            float k0 = o1 ? d[2] : d[0], k1 = o1 ? d[3] : d[1]; const float s0 = o1 ? d[0] : d[2], s1 = o1 ? d[1] : d[3];
            k0 += __shfl_xor(s0, 1); k1 += __shfl_xor(s1, 1);
            float kq = o2 ? k1 : k0; const float sq = o2 ? k0 : k1;
            kq += __shfl_xor(sq, 2);
            kq += __shfl_xor(kq, 4); kq += __shfl_xor(kq, 8); kq += __shfl_xor(kq, 16); kq += __shfl_xor(kq, 32);
            if (lane < 4) S[(wid * 32 + kk * 8 + j) * 4 + qi] = kq;
        }
#pragma unroll
        for (int j = 0; j < 8; ++j) kv[j] = kn[j];
    }
#pragma unroll
    for (int j = 0; j < 8; ++j) kv[j] = *(const f32x4*)(vp + (size_t)(wid * 32 + j) * DM);
    __syncthreads();
    if (wid < 4) {
        float s[4]; float mx = -3.0e38f;
#pragma unroll
        for (int j = 0; j < 4; ++j) { s[j] = S[(lane + 64 * j) * 4 + wid]; mx = fmaxf(mx, s[j]); }
        mx = wave_max(mx); float sum = 0.f;
#pragma unroll
        for (int j = 0; j < 4; ++j) { s[j] = __expf(s[j] - mx); sum += s[j]; }
        sum = wave_sum(sum); const float inv = 1.0f / sum;
#pragma unroll
        for (int j = 0; j < 4; ++j) S[(lane + 64 * j) * 4 + wid] = s[j] * inv;
    }
    __syncthreads();
    f32x4 acc[4];
#pragma unroll
    for (int i = 0; i < 4; ++i) acc[i] = (f32x4){0.f, 0.f, 0.f, 0.f};
#pragma unroll 1
    for (int kk = 0; kk < 4; ++kk) {
        if (kk < 3) {
#pragma unroll
            for (int j = 0; j < 8; ++j) kn[j] = *(const f32x4*)(vp + (size_t)(wid * 32 + (kk + 1) * 8 + j) * DM);
        }
#pragma unroll
        for (int j = 0; j < 8; ++j) { const f32x4 pv = *(const LAS f32x4*)(S + (wid * 32 + kk * 8 + j) * 4);
#pragma unroll
            for (int i = 0; i < 4; ++i) acc[i] = acc[i] + kv[j] * pv[i]; }
#pragma unroll
        for (int j = 0; j < 8; ++j) kv[j] = kn[j];
    }
#pragma unroll
    for (int i = 0; i < 4; ++i) *(LAS f32x4*)(RED + (wid * 4 + i) * 256 + 4 * lane) = acc[i];
    __syncthreads();
    { const int i = tid >> 7, d = (tid & 127) * 2; float o0 = 0.f, o1 = 0.f;
#pragma unroll
      for (int w = 0; w < 8; ++w) { const f32x2v v = *(const LAS f32x2v*)(RED + (w * 4 + i) * 256 + d); o0 += v.x; o1 += v.y; }
      *(unsigned*)(p.O() + (row0 + i) * DM + h * 256 + d) = pk2(o0, o1); }
    __syncthreads();
}
__device__ __forceinline__ void p5_attention(const Args& p, LAS unsigned char* lds, int G, int bid, int tid) {
    const int vcu = (G % 8 == 0) ? (bid % 8) * (G / 8) + bid / 8 : bid;
    if (vcu & 1) { for (int u = vcu; u < DECB * 4; u += G) attn_sample_unit(p, lds, u, tid); }
    for (int u = vcu; u < NBATCH * 4 * 8; u += G) attn_prompt_unit(p, lds, u, tid);
    if (!(vcu & 1)) { for (int u = vcu; u < DECB * 4; u += G) attn_sample_unit(p, lds, u, tid); }
}

__device__ __forceinline__ void p9_ln3(const Args& p, int G, int bid, int tid) {
    const int lane = tid & 63, gw = bid * 8 + (tid >> 6), NGW = G * 8;
    f32x4 g4[4], b4[4];
#pragma unroll
    for (int j = 0; j < 4; ++j) { g4[j] = ((const f32x4*)p.ln3_g())[lane + 64 * j]; b4[j] = ((const f32x4*)p.ln3_b())[lane + 64 * j]; }
    for (int m = gw; m < MT; m += NGW) {
        const f32x4* xi = (const f32x4*)(p.R1() + (size_t)m * DM) + lane; f32x4* xr = (f32x4*)(p.out() + OY + (size_t)m * DM) + lane;
        f32x4 v[4]; float s = 0.f;
#pragma unroll
        for (int j = 0; j < 4; ++j) { v[j] = xi[64 * j]; s += (v[j].x + v[j].y) + (v[j].z + v[j].w); }
        const float mean = wave_sum(s) * (1.0f / DM); float s2 = 0.f;
#pragma unroll
        for (int j = 0; j < 4; ++j) { v[j] = v[j] - mean; s2 += (v[j].x * v[j].x + v[j].y * v[j].y) + (v[j].z * v[j].z + v[j].w * v[j].w); }
        const float rstd = rsqrtf(wave_sum(s2) * (1.0f / DM) + LN_EPS);
#pragma unroll
        for (int j = 0; j < 4; ++j) xr[64 * j] = v[j] * rstd * g4[j] + b4[j];
    }
}

#define GEMM_PHASE(EpiT, E, A_, B_, M_, N_, K_, c_) do { pg8::Gemm g_{A_, B_, M_, N_, K_}; pg8::StaticOrder S_; S_.init(M_, N_, G, c_); \
        pg8::gemm_phase<EpiT, pg8::StaticOrder, true, true>(lds, g_, S_, E); } while (0)

__global__ void __launch_bounds__(512, 2) fwd_megakernel(Args a) {
    extern __shared__ __attribute__((aligned(16))) unsigned char lds_raw[];
    LAS unsigned char* lds = (LAS unsigned char*)lds_raw;
    cg::grid_group grid = cg::this_grid();
    const int tid = threadIdx.x, bid = blockIdx.x, G = gridDim.x;
    const Args& p = a;
    volatile LAS unsigned* misc = (volatile LAS unsigned*)(lds + 131072 + 1024);
    if (tid < 2) misc[tid] = 0u;
    __syncthreads();
    const XcdBarrier bar = xcd_barrier_post((unsigned*)p.ctl() + CW_BAR, misc);
    const int lo = a.ph_lo, hi = a.ph_hi;
#ifndef PH_MASK
#define PH_MASK 0x3ff
#endif
#define IN(k) (((PH_MASK >> (k)) & 1) && lo <= (k) && (k) < hi)
#define SEAM(k) do { if ((k) + 1 < hi) { if ((k) == 0) grid.sync(); else xcd_barrier(bar); } } while (0)

    if (IN(0)) { p0_prologue(p, lds, G, bid, tid); SEAM(0); }
    if (IN(1)) {
        { EpiIn E{p.b_in(), p.U(), p.P(), p.out()}; GEMM_PHASE(EpiIn, E, p.XB(), p.Win_t(), NPT, DIN, DM, bid); }
        { EpiKV E{p.out(), p.KB(), p.VT()}; const int rot = ((NPT / 256) * (DIN / 256)) % G; GEMM_PHASE(EpiKV, E, p.MB(), p.Wkv_t(), MEMROWS, 2 * DM, DM, (bid + G - rot) % G); }
        { SmallIn E{p.b_in(), p.U(), p.P(), p.out()}; small_gemm_phase(lds, p.XB(), p.Win_t(), DM, DM, DIN / 64, E, G - G / 4, G / 4, bid, tid); }
        SEAM(1);
    }
    if (IN(2)) { p2_mixer(p, G, bid, tid); SEAM(2); }
    if (IN(3)) { { typedef EpiRes<0, false, true, true, false> EpiT; EpiT E{p.XB(), nullptr, nullptr, nullptr, nullptr, p.R1B(), p.ctl() + CF_ST1, nullptr};
          GEMM_PHASE(EpiT, E, p.MIX(), p.Wout_t(), NPT, DM, DM, bid); }
        { SmallRes<0, false, true, true, false> E{p.XB(), nullptr, nullptr, nullptr, nullptr, p.R1B(), p.ctl() + CF_ST1, nullptr}; small_gemm_phase(lds, p.MIX(), p.Wout_t(), DM, DM, DM / 64, E, 0, G, bid, tid); }
        SEAM(3); }
    if (IN(4)) { { typedef EpiFold<0, false> EpiT; EpiT E{p.Q(), DM, p.ctl() + CF_ST1, p.ctl() + CF_C1Q, p.ctl() + CF_C2Q, nullptr, 0.0625f};
          GEMM_PHASE(EpiT, E, p.R1B(), p.Wq_t(), NPT, DM, DM, bid); }
        { SmallFold<0, false> E{p.Q(), DM, p.ctl() + CF_ST1, p.ctl() + CF_C1Q, p.ctl() + CF_C2Q, nullptr, 0.0625f}; small_gemm_phase(lds, p.R1B(), p.Wq_t(), DM, DM, DM / 64, E, 0, G, bid, tid); }
        SEAM(4); }
    if (IN(5)) { p5_attention(p, lds, G, bid, tid); SEAM(5); }
    if (IN(6)) { { typedef EpiRes<1, false, true, true, false> EpiT; EpiT E{p.R1B(), p.ctl() + CF_ST1, p.ln1_g(), p.ln1_b(), nullptr, p.R2B(), p.ctl() + CF_ST2, nullptr};
          GEMM_PHASE(EpiT, E, p.O(), p.Wo_t(), NPT, DM, DM, bid); }
        { SmallRes<1, false, true, true, false> E{p.R1B(), p.ctl() + CF_ST1, p.ln1_g(), p.ln1_b(), nullptr, p.R2B(), p.ctl() + CF_ST2, nullptr}; small_gemm_phase(lds, p.O(), p.Wo_t(), DM, DM, DM / 64, E, 0, G, bid, tid); }
        SEAM(6); }
    if (IN(7)) { { typedef EpiFold<1, true> EpiT; EpiT E{p.H(), DFF, p.ctl() + CF_ST2, p.ctl() + CF_C1H, p.ctl() + CF_C2H, p.b1(), 1.0f};
          GEMM_PHASE(EpiT, E, p.R2B(), p.W1_t(), NPT, DFF, DM, bid); }
        { SmallFold<1, true> E{p.H(), DFF, p.ctl() + CF_ST2, p.ctl() + CF_C1H, p.ctl() + CF_C2H, p.b1(), 1.0f}; small_gemm_phase(lds, p.R2B(), p.W1_t(), DM, DM, DFF / 64, E, 0, G, bid, tid); }
        SEAM(7); }
    if (IN(8)) { { typedef EpiRes<1, true, false, false, true> EpiT; EpiT E{p.R2B(), p.ctl() + CF_ST2, p.ln2_g(), p.ln2_b(), p.R1(), nullptr, nullptr, p.b2()};
          GEMM_PHASE(EpiT, E, p.H(), p.W2_t(), NPT, DM, DFF, bid); }
        { SmallRes<1, true, false, false, true> E{p.R2B(), p.ctl() + CF_ST2, p.ln2_g(), p.ln2_b(), p.R1(), nullptr, nullptr, p.b2()}; small_gemm_phase(lds, p.H(), p.W2_t(), DFF, DFF, DM / 64, E, 0, G, bid, tid); }
        SEAM(8); }
    if (IN(9)) { p9_ln3(p, G, bid, tid); }
#undef IN
#undef SEAM
}

extern "C" void kernel_launch(void* const* d_in, const int* in_sizes, int n_in, void* d_out, int out_size, void* d_ws, size_t ws_size, hipStream_t stream) {
    static int grid = 0;
    if (grid == 0) {
        if (n_in != 30 || (size_t)out_size != OEND || ws_size < WS_END) { fprintf(stderr, "kernel_launch: unexpected problem shape (n_in %d, out %d, ws %zu)\n", n_in, out_size, ws_size); grid = -1; return; }
        int dev = 0, cus = 0, per_cu = 0;
        if (hipGetDevice(&dev) != hipSuccess || hipDeviceGetAttribute(&cus, hipDeviceAttributeMultiprocessorCount, dev) != hipSuccess) { grid = -1; return; }
        if (hipFuncSetAttribute((const void*)fwd_megakernel, hipFuncAttributeMaxDynamicSharedMemorySize, LDS_BYTES) != hipSuccess) { fprintf(stderr, "kernel_launch: hipFuncSetAttribute failed\n"); grid = -1; return; }
        if (hipOccupancyMaxActiveBlocksPerMultiprocessor(&per_cu, (const void*)fwd_megakernel, 512, LDS_BYTES) != hipSuccess || per_cu < 1) { fprintf(stderr, "kernel_launch: occupancy query failed (%d)\n", per_cu); (void)hipGetLastError(); grid = -1; return; }
        grid = cus * per_cu;
    }
    if (grid < 0) return;
    (void)hipMemsetAsync((char*)d_ws + WS_CTL, 0, CTL_ZERO_BYTES, stream);
    Args a{};
    for (int i = 0; i < 30; ++i) a.in[i] = (const float*)d_in[i];
    a.outp = (float*)d_out; a.ws = (unsigned char*)d_ws;
#if MK_PER_PHASE
#ifndef EXTRA_MASK
#define EXTRA_MASK 0
#endif
    for (int ph = 0; ph < NPHASE; ++ph) { a.ph_lo = ph; a.ph_hi = ph + 1; hipLaunchKernelGGL(fwd_megakernel, dim3(grid), dim3(512), LDS_BYTES, stream, a);
        if ((EXTRA_MASK >> ph) & 1) {
            if (ph == 0) (void)hipMemsetAsync((char*)d_ws + WS_CTL, 0, CTL_ZERO_BYTES, stream);
            if (ph == 3) (void)hipMemsetAsync((char*)d_ws + WS_CTL + CF_ST1 * 4, 0, MT * 8, stream);
            if (ph == 6) (void)hipMemsetAsync((char*)d_ws + WS_CTL + CF_ST2 * 4, 0, MT * 8, stream);
            hipLaunchKernelGGL(fwd_megakernel, dim3(grid), dim3(512), LDS_BYTES, stream, a); } }
#else
    a.ph_lo = 0; a.ph_hi = NPHASE;
    void* args[] = {&a};
    hipError_t e = hipLaunchCooperativeKernel((const void*)fwd_megakernel, dim3(grid), dim3(512), args, LDS_BYTES, stream);
    if (e != hipSuccess) fprintf(stderr, "kernel_launch: cooperative launch failed: %s (grid %d)\n", hipGetErrorString(e), grid);
#endif
}
```

```cpp
#include <hip/hip_runtime.h>
#include <hip/hip_cooperative_groups.h>
#include <cstdio>
#include <cstdint>
namespace cg = cooperative_groups;
namespace pg8 {
#define PG8_LAS __attribute__((address_space(3)))
typedef unsigned short bf16_t;
typedef short bf16x8 __attribute__((ext_vector_type(8)));
typedef float f32x4 __attribute__((ext_vector_type(4)));
typedef unsigned u32x4 __attribute__((ext_vector_type(4)));
constexpr int BM = 256, BK = 64, HALF = 128, HTB = HALF * BK * 2  , STAGE_BYTES = 8 * HTB, NXCD = 8, WGM = 8;

__host__ __device__ __forceinline__ int lds_byte(int r, int c) { const int st = (r >> 4) * 2 + (c >> 5), rr = r & 15, cc = c & 31, ob = rr * 64 + cc * 2; return st * 1024 + (ob ^ (((ob >> 9) & 1) << 5)); }
__host__ __device__ __forceinline__ void stage_rc(int b, int& R, int& C) { const int st = b / 1024, sb = b % 1024, swz = sb ^ (((sb >> 9) & 1) << 5); R = (st >> 1) * 16 + swz / 64; C = (st & 1) * 32 + (swz % 64) / 2; }
__host__ __device__ __forceinline__ int perm32(int rho) { const int n = rho >> 4, i = rho & 15; return 8 * (i >> 2) + 4 * n + (i & 3); }

struct Unit { int pm, pn; };
struct Gemm { const bf16_t* A; const bf16_t* Bt; int M, N, K; };

struct StaticOrder {
    int nM, nN, nwg, G, c;
    __host__ __device__ void init(int M, int N, int G_, int c_) { nM = M / BM; nN = N / BM; nwg = nM * nN; G = G_; c = c_; }
    __host__ __device__ bool next(int i, Unit& u) const {
        const long L = (long)i * G + c; if (L >= nwg) return false;
        int wgid = (int)L; { const int q = nwg / NXCD, r = nwg % NXCD, xcd = wgid % NXCD, off = wgid / NXCD; wgid = (xcd < r ? xcd * (q + 1) : r * (q + 1) + (xcd - r) * q) + off; }
        const int nig = WGM * nN, gid = wgid / nig, fm = gid * WGM, gsz = (nM - fm) < WGM ? (nM - fm) : WGM;
        u.pm = fm + ((wgid % nig) % gsz); u.pn = (wgid % nig) / gsz; return true;
    }
    __device__ __forceinline__ void a_ready(const Unit&) const {}
    __device__ __forceinline__ void done(const Unit&) const {}
};

__device__ __forceinline__ unsigned cvt_pk_bf16(float lo, float hi) { unsigned r; asm volatile("v_cvt_pk_bf16_f32 %0, %1, %2" : "=v"(r) : "v"(lo), "v"(hi)); return r; }
typedef float f32x2 __attribute__((ext_vector_type(2)));
template <class Epi, class Sched, bool ALIGN_EPI = false, bool SP2 = false>
__device__ __forceinline__ void gemm_phase(PG8_LAS unsigned char* lds, const Gemm g, const Sched& S, const Epi& E) {
    const int tid = threadIdx.x, wid = __builtin_amdgcn_readfirstlane(tid >> 6), lane = tid & 63, wr = wid >> 2, wc = wid & 3, fr = lane & 15, fq = lane >> 4;
    const int K = g.K, nt = K / BK;
    unsigned voffA[2], voffB[2];
#pragma unroll
    for (int i = 0; i < 2; ++i) { int R, C; stage_rc(tid * 16 + i * 8192, R, C); const int Rb = Epi::PERM ? ((R & ~31) + perm32(R & 31)) : R;
        voffA[i] = (unsigned)(R * K + C) * 2u; voffB[i] = (unsigned)(Rb * K + C) * 2u; }
    const size_t kstep = (size_t)(BK * 2);
    const size_t hstep = (size_t)HALF * K * 2;
    const size_t tstep = 2 * hstep;
    const unsigned ldsw = (unsigned)wid * 1024u;
    const int aoff = lds_byte(wr * 64 + fr, fq * 8), boff = lds_byte(wc * 32 + fr, fq * 8);
#define PG8_SA(b, h) (((b) * 2 + (h)) * HTB)
#define PG8_SB(b, h) ((4 + (b) * 2 + (h)) * HTB)
#define PG8_STAGE(bufoff, gbase, voff) do { _Pragma("unroll") for (int _i = 0; _i < 2; ++_i) \
        __builtin_amdgcn_global_load_lds((const unsigned*)((const char*)(gbase) + (voff)[_i]), (PG8_LAS unsigned*)(lds + (bufoff) + ldsw + _i * 8192), 16, 0, 0); } while (0)
#define PG8_LDA(dst, b, h) do { _Pragma("unroll") for (int m = 0; m < 4; ++m) _Pragma("unroll") for (int k = 0; k < 2; ++k) dst[m][k] = *(const PG8_LAS bf16x8*)(lds + PG8_SA(b, h) + aoff + m * 2048 + k * 1024); } while (0)
#define PG8_LDB(dst, b, h) do { _Pragma("unroll") for (int n = 0; n < 2; ++n) _Pragma("unroll") for (int k = 0; k < 2; ++k) dst[n][k] = *(const PG8_LAS bf16x8*)(lds + PG8_SB(b, h) + boff + n * 2048 + k * 1024); } while (0)
#define PG8_MMA(ai, bj, At, Bt) do { __builtin_amdgcn_s_setprio(1); _Pragma("unroll") for (int m = 0; m < 4; ++m) _Pragma("unroll") for (int n = 0; n < 2; ++n) _Pragma("unroll") for (int k = 0; k < 2; ++k) \
        acc[ai][bj][m][n] = __builtin_amdgcn_mfma_f32_16x16x32_bf16(Bt[n][k], At[m][k], acc[ai][bj][m][n], 0, 0, 0); __builtin_amdgcn_s_setprio(0); } while (0)
#define PG8_WAIT_V(n) asm volatile("s_waitcnt vmcnt(" #n ")" ::: "memory")
#define PG8_WAIT_L(n) asm volatile("s_waitcnt lgkmcnt(" #n ")" ::: "memory")
#define PG8_BAR __builtin_amdgcn_s_barrier()
#define PG8_SCHED __builtin_amdgcn_sched_barrier(0)
    Unit cur, nxt; int ui = 0;
    if (!S.next(0, cur)) return;
    f32x4 acc[2][2][4][2];
#pragma unroll
    for (int a = 0; a < 2; ++a)
#pragma unroll
        for (int b = 0; b < 2; ++b)
#pragma unroll
            for (int m = 0; m < 4; ++m)
#pragma unroll
                for (int n = 0; n < 2; ++n) acc[a][b][m][n] = (f32x4){0.f, 0.f, 0.f, 0.f};
    bf16x8 At[4][2], B0[2][2], B1[2][2];
    const char* cA = (const char*)g.A + (size_t)cur.pm * tstep; const char* cB = (const char*)g.Bt + (size_t)cur.pn * tstep;
    S.a_ready(cur);
    if constexpr (SP2) {
        PG8_STAGE(PG8_SB(0, 0), cB, voffB); PG8_STAGE(PG8_SB(0, 1), cB + hstep, voffB); PG8_STAGE(PG8_SA(0, 0), cA, voffA); PG8_STAGE(PG8_SA(0, 1), cA + hstep, voffA);
        if (wr == 1) PG8_BAR;
        PG8_WAIT_V(2); PG8_BAR;
        PG8_STAGE(PG8_SB(1, 0), cB + kstep, voffB); PG8_STAGE(PG8_SA(1, 0), cA + kstep, voffA); PG8_STAGE(PG8_SB(1, 1), cB + hstep + kstep, voffB);
        PG8_WAIT_V(6); PG8_BAR;
    } else {
        PG8_STAGE(PG8_SB(0, 0), cB, voffB); PG8_STAGE(PG8_SA(0, 0), cA, voffA); PG8_STAGE(PG8_SB(0, 1), cB + hstep, voffB); PG8_STAGE(PG8_SA(0, 1), cA + hstep, voffA);
        if (wr == 1) PG8_BAR;
        PG8_WAIT_V(4); PG8_BAR;
        PG8_STAGE(PG8_SB(1, 0), cB + kstep, voffB); PG8_STAGE(PG8_SA(1, 0), cA + kstep, voffA); PG8_STAGE(PG8_SB(1, 1), cB + hstep + kstep, voffB);
        PG8_WAIT_V(6); PG8_BAR;
    }
    for (;;) {
        const bool has_next = S.next(ui + 1, nxt);
        const char* nA = has_next ? (const char*)g.A + (size_t)nxt.pm * tstep : cA; const char* nB = has_next ? (const char*)g.Bt + (size_t)nxt.pn * tstep : cB;
        for (int t = 0; t < nt; t += 2) {
            const bool last = (t == nt - 2);
            const char* a1 = cA + (size_t)(t + 1) * kstep;
            const char* a2 = last ? nA : cA + (size_t)(t + 2) * kstep; const char* b2 = last ? nB : cB + (size_t)(t + 2) * kstep;
            const char* a3 = a2 + kstep; const char* b3 = b2 + kstep;
            if (last && has_next) S.a_ready(nxt);
            if constexpr (SP2) {
            PG8_LDB(B0, 0, 0); PG8_LDB(B1, 0, 1); PG8_SCHED; PG8_LDA(At, 0, 0); PG8_STAGE(PG8_SA(1, 1), a1 + hstep, voffA);
            PG8_WAIT_V(8); PG8_WAIT_L(0); PG8_BAR; PG8_MMA(0, 0, At, B0); PG8_MMA(0, 1, At, B1); PG8_BAR; PG8_SCHED;
            PG8_LDA(At, 0, 1); PG8_STAGE(PG8_SB(0, 0), b2, voffB); PG8_STAGE(PG8_SB(0, 1), b2 + hstep, voffB); PG8_STAGE(PG8_SA(0, 0), a2, voffA);
            PG8_WAIT_V(8); PG8_WAIT_L(0); PG8_BAR; PG8_MMA(1, 0, At, B0); PG8_MMA(1, 1, At, B1); PG8_BAR; PG8_SCHED;
            PG8_LDB(B0, 1, 0); PG8_LDB(B1, 1, 1); PG8_SCHED; PG8_LDA(At, 1, 0); PG8_STAGE(PG8_SA(0, 1), a2 + hstep, voffA);
            PG8_WAIT_V(8); PG8_WAIT_L(0); PG8_BAR; PG8_MMA(0, 0, At, B0); PG8_MMA(0, 1, At, B1); PG8_BAR; PG8_SCHED;
            PG8_LDA(At, 1, 1); PG8_STAGE(PG8_SB(1, 0), b3, voffB); PG8_STAGE(PG8_SB(1, 1), b3 + hstep, voffB); PG8_STAGE(PG8_SA(1, 0), a3, voffA);
            PG8_WAIT_V(8); PG8_WAIT_L(0); PG8_BAR; PG8_MMA(1, 0, At, B0); PG8_MMA(1, 1, At, B1); PG8_BAR; PG8_SCHED;
            } else {
            PG8_LDB(B0, 0, 0); PG8_SCHED; PG8_LDA(At, 0, 0); PG8_STAGE(PG8_SA(1, 1), a1 + hstep, voffA);
            PG8_WAIT_L(8); PG8_BAR; PG8_WAIT_L(0); PG8_MMA(0, 0, At, B0); PG8_BAR; PG8_SCHED;
            PG8_LDB(B1, 0, 1); PG8_STAGE(PG8_SB(0, 0), b2, voffB);
            PG8_BAR; PG8_WAIT_L(0); PG8_MMA(0, 1, At, B1); PG8_BAR;
            PG8_LDA(At, 0, 1); PG8_STAGE(PG8_SA(0, 0), a2, voffA);
            PG8_BAR; PG8_WAIT_L(0); PG8_MMA(1, 0, At, B0); PG8_BAR; PG8_SCHED;
            PG8_STAGE(PG8_SB(0, 1), b2 + hstep, voffB);
            PG8_WAIT_V(6); PG8_BAR; PG8_MMA(1, 1, At, B1); PG8_BAR;
            PG8_LDB(B0, 1, 0); PG8_SCHED; PG8_LDA(At, 1, 0); PG8_STAGE(PG8_SA(0, 1), a2 + hstep, voffA);
            PG8_WAIT_L(8); PG8_BAR; PG8_WAIT_L(0); PG8_MMA(0, 0, At, B0); PG8_BAR; PG8_SCHED;
            PG8_LDB(B1, 1, 1); PG8_STAGE(PG8_SB(1, 0), b3, voffB);
            PG8_BAR; PG8_WAIT_L(0); PG8_MMA(0, 1, At, B1); PG8_BAR;
            PG8_LDA(At, 1, 1); PG8_STAGE(PG8_SA(1, 0), a3, voffA);
            PG8_BAR; PG8_WAIT_L(0); PG8_MMA(1, 0, At, B0); PG8_BAR; PG8_SCHED;
            PG8_STAGE(PG8_SB(1, 1), b3 + hstep, voffB);
            PG8_WAIT_V(6); PG8_BAR; PG8_MMA(1, 1, At, B1); PG8_BAR;
            }
        }
        if constexpr (ALIGN_EPI) { if (wr == 0) PG8_BAR; }
        if constexpr (!Epi::AFTER_DRAIN) { E(acc, cur, wr, wc, fr, fq); S.done(cur); }
        if (!has_next) break;
#pragma unroll
        for (int a = 0; a < 2; ++a)
#pragma unroll
            for (int b = 0; b < 2; ++b)
#pragma unroll
                for (int m = 0; m < 4; ++m)
#pragma unroll
                    for (int n = 0; n < 2; ++n) acc[a][b][m][n] = (f32x4){0.f, 0.f, 0.f, 0.f};
        cur = nxt; cA = nA; cB = nB; ++ui;
        if constexpr (ALIGN_EPI) { if (wr == 1) PG8_BAR; }
    }
    PG8_WAIT_V(0);
    if constexpr (!ALIGN_EPI) { if (wr == 0) PG8_BAR; }
    PG8_BAR;
    if constexpr (Epi::AFTER_DRAIN) { E.fused(acc, cur, wr, wc, fr, fq, lds, wid, lane); S.done(cur); }
#undef PG8_SA
#undef PG8_SB
#undef PG8_STAGE
#undef PG8_LDA
#undef PG8_LDB
#undef PG8_MMA
#undef PG8_WAIT_V
#undef PG8_WAIT_L
#undef PG8_BAR
#undef PG8_SCHED
}
}

#ifndef MK_PER_PHASE
#define MK_PER_PHASE 0
#endif
#define LAS __attribute__((address_space(3)))
using pg8::bf16_t; using pg8::f32x4; using pg8::u32x4; using pg8::bf16x8; using pg8::Unit;
typedef unsigned u32x2 __attribute__((ext_vector_type(2)));
typedef float f32x2v __attribute__((ext_vector_type(2)));
typedef __bf16 b16x2v __attribute__((ext_vector_type(2)));
typedef float f32x16 __attribute__((ext_vector_type(16)));
typedef short s16x4 __attribute__((ext_vector_type(4)));

constexpr int DM = 1024, SEQ = 2048, NBATCH = 8, NPT = NBATCH * SEQ, DECB = 128, DECS = 4, NST = DECB * DECS, MT = NPT + NST;
constexpr int NMEM = 256, MEMROWS = NBATCH * NMEM, DFF = 4096, DIN = 1536, DC = 512;
constexpr float LN_EPS = 1e-5f, DN_ALPHA = 1.18920711500272f;
constexpr int NPHASE = 10;

constexpr size_t OY = 0, OMK = (size_t)MT * DM, OMV = OMK + (size_t)MEMROWS * DM, OCP = OMV + (size_t)MEMROWS * DM, OCS = OCP + (size_t)NBATCH * 30 * 512,
                 OPP = OCS + (size_t)DECB * 30 * 512, OPS = OPP + (size_t)NBATCH * 15 * 512, OEND = OPS + (size_t)DECB * 15 * 512;
constexpr size_t MiB = 1u << 20;
constexpr size_t WS_CTL = 0, CTL_ZERO_BYTES = 512 * 1024;
constexpr size_t WS_WIN = 2 * MiB, WS_WKV = 5 * MiB, WS_WOUT = 9 * MiB, WS_WQ = 11 * MiB, WS_WO = 13 * MiB, WS_W1 = 15 * MiB, WS_W2 = 23 * MiB;
constexpr size_t WS_KB = 31 * MiB, WS_VT = 35 * MiB, WS_MB = 39 * MiB;
constexpr size_t WS_XB = 44 * MiB, WS_U = 77 * MiB, WS_P = WS_U + (size_t)MT * DC * 2, WS_MIX = 110 * MiB, WS_R1B = 143 * MiB, WS_Q = 176 * MiB, WS_O = 209 * MiB;
constexpr size_t WS_R1 = 242 * MiB, WS_R2 = 308 * MiB, WS_R2B = 374 * MiB, WS_END = 407 * MiB;
constexpr size_t WS_H = 44 * MiB;
static_assert(WS_H + (size_t)MT * DFF * 2 <= WS_Q, "H overlay");
constexpr int CF_ST1 = 0, CF_ST2 = 34816, CF_C1Q = 69632, CF_C2Q = 70656, CF_C1H = 71680, CF_C2H = 75776, CF_END = 79872, CW_BAR = 81920;
static_assert((CW_BAR + 3456) * 4 <= (int)CTL_ZERO_BYTES && CF_END <= CW_BAR && MT * 2 <= CF_ST2, "ctl");

constexpr int LDS_BYTES = 131072 + 4096;

__device__ __forceinline__ unsigned pk2(float lo, float hi) { f32x2v v = {lo, hi}; b16x2v b = __builtin_convertvector(v, b16x2v); return __builtin_bit_cast(unsigned, b); }
__device__ __forceinline__ float bflo(unsigned v) { return __uint_as_float(v << 16); }
__device__ __forceinline__ float bfhi(unsigned v) { return __uint_as_float(v & 0xffff0000u); }
__device__ __forceinline__ float wave_sum(float v) {
#pragma unroll
    for (int o = 1; o < 64; o <<= 1) v += __shfl_xor(v, o);
    return v;
}
__device__ __forceinline__ float wave_max(float v) {
#pragma unroll
    for (int o = 1; o < 64; o <<= 1) v = fmaxf(v, __shfl_xor(v, o));
    return v;
}
__device__ __forceinline__ float fsigmoid(float x) { return __builtin_amdgcn_rcpf(1.0f + __expf(-x)); }

struct Args {
    const float* in[30]; float* outp; unsigned char* ws; int ph_lo, ph_hi;
    __device__ __forceinline__ const float* x_prompt() const { return in[0]; }
    __device__ __forceinline__ const float* x_sample() const { return in[1]; }
    __device__ __forceinline__ const float* mem_prompt() const { return in[2]; }
    __device__ __forceinline__ const float* cache_k() const { return in[3]; }
    __device__ __forceinline__ const float* cache_v() const { return in[4]; }
    __device__ __forceinline__ const float* state_conv() const { return in[5]; }
    __device__ __forceinline__ const float* state_pool() const { return in[6]; }
    __device__ __forceinline__ const float* w_in() const { return in[7]; }
    __device__ __forceinline__ const float* b_in() const { return in[8]; }
    __device__ __forceinline__ const float* conv_w() const { return in[9]; }
    __device__ __forceinline__ const float* conv_b() const { return in[10]; }
    __device__ __forceinline__ const float* gn_g() const { return in[11]; }
    __device__ __forceinline__ const float* gn_b() const { return in[12]; }
    __device__ __forceinline__ const float* pool_w() const { return in[13]; }
    __device__ __forceinline__ const float* pool_scale() const { return in[14]; }
    __device__ __forceinline__ const float* w_out() const { return in[15]; }
    __device__ __forceinline__ const float* ln1_g() const { return in[16]; }
    __device__ __forceinline__ const float* ln1_b() const { return in[17]; }
    __device__ __forceinline__ const float* xq_w() const { return in[18]; }
    __device__ __forceinline__ const float* xk_w() const { return in[19]; }
    __device__ __forceinline__ const float* xv_w() const { return in[20]; }
    __device__ __forceinline__ const float* xo_w() const { return in[21]; }
    __device__ __forceinline__ const float* ln2_g() const { return in[22]; }
    __device__ __forceinline__ const float* ln2_b() const { return in[23]; }
    __device__ __forceinline__ const float* w1() const { return in[24]; }
    __device__ __forceinline__ const float* b1() const { return in[25]; }
    __device__ __forceinline__ const float* w2() const { return in[26]; }
    __device__ __forceinline__ const float* b2() const { return in[27]; }
    __device__ __forceinline__ const float* ln3_g() const { return in[28]; }
    __device__ __forceinline__ const float* ln3_b() const { return in[29]; }
    __device__ __forceinline__ float* out() const { return outp; }
    __device__ __forceinline__ float* ctl() const { return (float*)(ws + WS_CTL); }
    __device__ __forceinline__ bf16_t* Win_t() const { return (bf16_t*)(ws + WS_WIN); }
    __device__ __forceinline__ bf16_t* Wkv_t() const { return (bf16_t*)(ws + WS_WKV); }
    __device__ __forceinline__ bf16_t* Wout_t() const { return (bf16_t*)(ws + WS_WOUT); }
    __device__ __forceinline__ bf16_t* Wq_t() const { return (bf16_t*)(ws + WS_WQ); }
    __device__ __forceinline__ bf16_t* Wo_t() const { return (bf16_t*)(ws + WS_WO); }
    __device__ __forceinline__ bf16_t* W1_t() const { return (bf16_t*)(ws + WS_W1); }
    __device__ __forceinline__ bf16_t* W2_t() const { return (bf16_t*)(ws + WS_W2); }
    __device__ __forceinline__ bf16_t* KB() const { return (bf16_t*)(ws + WS_KB); }
    __device__ __forceinline__ bf16_t* VT() const { return (bf16_t*)(ws + WS_VT); }
    __device__ __forceinline__ bf16_t* MB() const { return (bf16_t*)(ws + WS_MB); }
    __device__ __forceinline__ bf16_t* XB() const { return (bf16_t*)(ws + WS_XB); }
    __device__ __forceinline__ bf16_t* U() const { return (bf16_t*)(ws + WS_U); }
    __device__ __forceinline__ bf16_t* P() const { return (bf16_t*)(ws + WS_P); }
    __device__ __forceinline__ bf16_t* MIX() const { return (bf16_t*)(ws + WS_MIX); }
    __device__ __forceinline__ bf16_t* R1B() const { return (bf16_t*)(ws + WS_R1B); }
    __device__ __forceinline__ bf16_t* Q() const { return (bf16_t*)(ws + WS_Q); }
    __device__ __forceinline__ bf16_t* O() const { return (bf16_t*)(ws + WS_O); }
    __device__ __forceinline__ bf16_t* R2B() const { return (bf16_t*)(ws + WS_R2B); }
    __device__ __forceinline__ bf16_t* H() const { return (bf16_t*)(ws + WS_H); }
    __device__ __forceinline__ float* R1() const { return (float*)(ws + WS_R1); }
    __device__ __forceinline__ float* R2() const { return (float*)(ws + WS_R2); }
};

#define XB_TMO      128
#define XB_XCNT(j)  (256  + 64 * (j))
#define XB_XSUB(j)  (1280 + 64 * (j))
#define XB_XGEN(j)  (2304 + 64 * (j))
#define XB_TOP      3328
#define XB_TOPGEN   3392
#define XCD_BAR_WORDS 3456
#define XB_SPIN_CAP (1u << 18)

__device__ __forceinline__ unsigned xb_ld(unsigned* p)              { return __hip_atomic_load(p, __ATOMIC_RELAXED, __HIP_MEMORY_SCOPE_AGENT); }
__device__ __forceinline__ unsigned xb_add(unsigned* p, unsigned v) { return __hip_atomic_fetch_add(p, v, __ATOMIC_RELAXED, __HIP_MEMORY_SCOPE_AGENT); }
__device__ __forceinline__ unsigned xb_xcc_id() { return (unsigned)__builtin_amdgcn_s_getreg((3 << 11) | 20) & 0xFu; }
#define XB_SPIN(cond, bar) do { unsigned _sp = 0; while (cond) { __builtin_amdgcn_s_sleep(1); \
    if ((++_sp & 255u) == 0u) { if (xb_ld(&(bar)[XB_TMO])) break; if (_sp > XB_SPIN_CAP) { atomicAdd(&(bar)[XB_TMO], 1u); break; } } } } while (0)

struct XcdBarrier {
    unsigned* bar; unsigned x;
    volatile LAS unsigned* st;
};

__device__ __forceinline__ XcdBarrier xcd_barrier_post(unsigned* bar, volatile LAS unsigned* st) {
    XcdBarrier b; b.bar = bar; b.x = xb_xcc_id(); b.st = st;
    if (threadIdx.x == 0) (void)xb_add(&bar[XB_XCNT(b.x)], 1u);
    return b;
}
__device__ __forceinline__ void xcd_barrier_complete(unsigned* bar, unsigned x, unsigned& nloc, unsigned& nx) {
    const unsigned G = gridDim.x * gridDim.y * gridDim.z;
    unsigned sum, cnt, mine, sp = 0u;
    for (;;) {
        sum = 0u; cnt = 0u; mine = 0u;
#pragma unroll
        for (unsigned j = 0; j < 16; ++j) { const unsigned c = xb_ld(&bar[XB_XCNT(j)]); sum += c; cnt += (c > 0u) ? 1u : 0u; mine = (j == x) ? c : mine; }
        if (sum == G) break;
        __builtin_amdgcn_s_sleep(1);
        if ((++sp & 255u) == 0u) { if (xb_ld(&bar[XB_TMO])) break; if (sp > XB_SPIN_CAP) { atomicAdd(&bar[XB_TMO], 1u); break; } }
    }
    nloc = mine > 0u ? mine : 1u; nx = cnt > 0u ? cnt : 1u;
}

__device__ __forceinline__ void xcd_barrier(const XcdBarrier& b) {
    asm volatile("s_waitcnt vmcnt(0)" ::: "memory");
    __syncthreads();
    if (threadIdx.x == 0) {
        unsigned* bar = b.bar;
        __builtin_amdgcn_s_waitcnt(0);
        unsigned nloc = b.st[0], nx = b.st[1];
        if (nloc == 0u) { xcd_barrier_complete(bar, b.x, nloc, nx); b.st[0] = nloc; b.st[1] = nx; }
        const unsigned old = xb_add(&bar[XB_XSUB(b.x)], 1u);
        const unsigned gen = old / nloc;
        if (old + 1u == (gen + 1u) * nloc) {
            __builtin_amdgcn_fence(__ATOMIC_RELEASE, "agent");
            asm volatile("s_waitcnt vmcnt(0)" ::: "memory");
            const unsigned og = xb_add(&bar[XB_TOP], 1u);
            const unsigned tg = og / nx;
            if (og + 1u == (tg + 1u) * nx) xb_add(&bar[XB_TOPGEN], 1u);
            else XB_SPIN(xb_ld(&bar[XB_TOPGEN]) == tg, bar);
            __builtin_amdgcn_fence(__ATOMIC_ACQUIRE, "agent");
            xb_add(&bar[XB_XGEN(b.x)], 1u);
            asm volatile("s_waitcnt vmcnt(0)" ::: "memory");
        } else {
            XB_SPIN(xb_ld(&bar[XB_XGEN(b.x)]) == gen, bar);
            __builtin_amdgcn_fence(__ATOMIC_ACQUIRE, "agent");
            asm volatile("s_waitcnt vmcnt(0)" ::: "memory");
        }
    }
    __syncthreads();
}

__device__ __forceinline__ int win_dest(int n) {
    if (n < 512) return 32 * (n >> 4) + (n & 15);
    if (n < 1024) { const int c = n - 512; return 32 * (c >> 4) + 16 + (c & 15); }
    return n;
}
template <int MODE>
__device__ __forceinline__ void tr_item(const float* __restrict__ W, int N, bf16_t* WT, int ldk, int row_off, LAS float* scr, int kb, int nb, int lane,
                                        const float* g, const float* b, float* c1, float* c2) {
    const int k0 = 64 * kb, n0 = 32 * nb;
    float tv[32];
#pragma unroll
    for (int i = 0; i < 32; ++i) tv[i] = W[(size_t)(k0 + 2 * i + (lane >> 5)) * N + n0 + (lane & 31)];
#pragma unroll
    for (int i = 0; i < 32; ++i) scr[(2 * i + (lane >> 5)) * 33 + (lane & 31)] = tv[i];
    asm volatile("s_waitcnt lgkmcnt(0)" ::: "memory");
    if (MODE == 2) {
        const float* vec = (lane < 32) ? g : b; float s = 0.f;
#pragma unroll 8
        for (int k = 0; k < 64; ++k) s += vec[k0 + k] * scr[k * 33 + (lane & 31)];
        atomicAdd(((lane < 32) ? c1 : c2) + n0 + (lane & 31), s);
    }
    const int c = lane & 7;
    float gs[8];
#pragma unroll
    for (int i = 0; i < 8; ++i) gs[i] = (MODE == 2) ? g[k0 + 8 * c + i] : 1.0f;
#pragma unroll
    for (int j = 0; j < 4; ++j) { const int n = (lane >> 3) + 8 * j; const LAS float* s = scr + (8 * c) * 33 + n;
        u32x4 o; o.x = pk2(s[0 * 33] * gs[0], s[1 * 33] * gs[1]); o.y = pk2(s[2 * 33] * gs[2], s[3 * 33] * gs[3]); o.z = pk2(s[4 * 33] * gs[4], s[5 * 33] * gs[5]); o.w = pk2(s[6 * 33] * gs[6], s[7 * 33] * gs[7]);
        const int dr = (MODE == 1) ? win_dest(n0 + n) : (n0 + n);
        *(u32x4*)(WT + (size_t)(row_off + dr) * ldk + k0 + 8 * c) = o; }
    asm volatile("s_waitcnt lgkmcnt(0)" ::: "memory");
}
__device__ __forceinline__ void poolfold_block(const Args& p, LAS unsigned char* lds, int item, int tid) {
    const int g = item >> 5, nb = item & 31;
    LAS float* PW = (LAS float*)lds;
    LAS float* WO = (LAS float*)(lds + 128 * 132 * 4);
    const float* pw = p.pool_w() + (size_t)g * 16384;
#pragma unroll
    for (int i = 0; i < 8; ++i) { const int idx = tid + 512 * i; *(LAS f32x4*)(PW + (idx >> 5) * 132 + 4 * (idx & 31)) = ((const f32x4*)pw)[idx]; }
#pragma unroll
    for (int i = 0; i < 8; ++i) { const int idx = tid + 512 * i, d = idx >> 5, n = idx & 31; WO[idx] = p.w_out()[(size_t)(512 + 128 * g + d) * DM + 32 * nb + n] * p.pool_scale()[128 * g + d]; }
    __syncthreads();
    const int n = tid & 31, cg = tid >> 5;
    float acc[8];
#pragma unroll
    for (int j = 0; j < 8; ++j) acc[j] = 0.f;
#pragma unroll 4
    for (int d4 = 0; d4 < 32; ++d4) {
        const float w0 = WO[(4 * d4 + 0) * 32 + n], w1 = WO[(4 * d4 + 1) * 32 + n], w2 = WO[(4 * d4 + 2) * 32 + n], w3 = WO[(4 * d4 + 3) * 32 + n];
#pragma unroll
        for (int j = 0; j < 8; ++j) { const f32x4 q = *(const LAS f32x4*)(PW + (cg * 8 + j) * 132 + 4 * d4); acc[j] = fmaf(q[0], w0, fmaf(q[1], w1, fmaf(q[2], w2, fmaf(q[3], w3, acc[j])))); }
    }
    u32x4 o; o.x = pk2(acc[0], acc[1]); o.y = pk2(acc[2], acc[3]); o.z = pk2(acc[4], acc[5]); o.w = pk2(acc[6], acc[7]);
    *(u32x4*)(p.Wout_t() + (size_t)(32 * nb + n) * DM + 512 + 128 * g + cg * 8) = o;
    __syncthreads();
}
__device__ __forceinline__ void row_to_bf16(const float* xrow, bf16_t* orow, int lane) {
    const f32x4* xr = (const f32x4*)xrow + lane; unsigned long long* o8 = (unsigned long long*)orow + lane;
    f32x4 v[4];
#pragma unroll
    for (int j = 0; j < 4; ++j) v[j] = xr[64 * j];
#pragma unroll
    for (int j = 0; j < 4; ++j) o8[64 * j] = (unsigned long long)pk2(v[j].x, v[j].y) | ((unsigned long long)pk2(v[j].z, v[j].w) << 32);
}
__device__ __forceinline__ void p0_prologue(const Args& p, LAS unsigned char* lds, int G, int bid, int tid) {
    const int lane = tid & 63, wave = tid >> 6;
    LAS float* scr = (LAS float*)(lds + wave * 16384);
    const int gw = bid * 8 + wave, NGW = G * 8;
    constexpr int I_IN = 16 * 48, I_K = 16 * 32, I_V = I_K, I_OUT = 8 * 32, I_Q = I_K, I_O = I_K, I_1 = 16 * 128, I_2 = 64 * 32;
    constexpr int NITEMS = I_IN + I_K + I_V + I_OUT + I_Q + I_O + I_1 + I_2;
    for (int it = bid; it < 128; it += G) poolfold_block(p, lds, it, tid);
    for (int it = gw; it < NITEMS; it += NGW) {
        int r = it;
        if (r < I_IN) { tr_item<1>(p.w_in(), DIN, p.Win_t(), DM, 0, scr, r / 48, r % 48, lane, nullptr, nullptr, nullptr, nullptr); continue; } r -= I_IN;
        if (r < I_K) { tr_item<0>(p.xk_w(), DM, p.Wkv_t(), DM, 0, scr, r / 32, r % 32, lane, nullptr, nullptr, nullptr, nullptr); continue; } r -= I_K;
        if (r < I_V) { tr_item<0>(p.xv_w(), DM, p.Wkv_t(), DM, DM, scr, r / 32, r % 32, lane, nullptr, nullptr, nullptr, nullptr); continue; } r -= I_V;
        if (r < I_OUT) { tr_item<0>(p.w_out(), DM, p.Wout_t(), DM, 0, scr, r / 32, r % 32, lane, nullptr, nullptr, nullptr, nullptr); continue; } r -= I_OUT;
        if (r < I_Q) { tr_item<2>(p.xq_w(), DM, p.Wq_t(), DM, 0, scr, r / 32, r % 32, lane, p.ln1_g(), p.ln1_b(), p.ctl() + CF_C1Q, p.ctl() + CF_C2Q); continue; } r -= I_Q;
        if (r < I_O) { tr_item<0>(p.xo_w(), DM, p.Wo_t(), DM, 0, scr, r / 32, r % 32, lane, nullptr, nullptr, nullptr, nullptr); continue; } r -= I_O;
        if (r < I_1) { tr_item<2>(p.w1(), DFF, p.W1_t(), DM, 0, scr, r / 128, r % 128, lane, p.ln2_g(), p.ln2_b(), p.ctl() + CF_C1H, p.ctl() + CF_C2H); continue; } r -= I_1;
        tr_item<0>(p.w2(), DM, p.W2_t(), DFF, 0, scr, r / 32, r % 32, lane, nullptr, nullptr, nullptr, nullptr);
    }
    const int gt = bid * 512 + tid, NT = G * 512;
#define CVT_REGION(src, dst, n4) do { const f32x4* s4_ = (const f32x4*)(src); unsigned long long* d8_ = (unsigned long long*)(dst); \
        _Pragma("unroll 4") for (int i_ = gt; i_ < (n4); i_ += NT) { const f32x4 v_ = s4_[i_]; d8_[i_] = (unsigned long long)pk2(v_.x, v_.y) | ((unsigned long long)pk2(v_.z, v_.w) << 32); } } while (0)
    CVT_REGION(p.x_prompt(), p.XB(), NPT * (DM / 4));
    CVT_REGION(p.x_sample(), p.XB() + (size_t)NPT * DM, NST * (DM / 4));
    CVT_REGION(p.mem_prompt(), p.MB(), MEMROWS * (DM / 4));
#undef CVT_REGION
    for (int i = gt; i < DECB * 3328; i += NT) { const int sb = i / 3328, o = i % 3328; ((f32x4*)(p.out() + OCS + (size_t)sb * 15360))[o] = ((const f32x4*)(p.state_conv() + (size_t)sb * 15360 + 2048))[o]; }
    for (int i = gt; i < DECB * 1408; i += NT) { const int sb = i / 1408, o = i % 1408; ((f32x4*)(p.out() + OPS + (size_t)sb * 7680))[o] = ((const f32x4*)(p.state_pool() + (size_t)sb * 7680 + 2048))[o]; }
}

struct EpiIn {
    static constexpr bool PERM = false, AFTER_DRAIN = false;
    const float* b_in; bf16_t* U; bf16_t* P; float* out;
    __device__ __forceinline__ void operator()(const f32x4 (&acc)[2][2][4][2], const Unit& u, int wr, int wc, int fr, int fq) const {
        if (u.pn < 4) {
#pragma unroll
            for (int bj = 0; bj < 2; ++bj) {
                const int ch = 16 * (8 * u.pn + 4 * bj + wc) + 4 * fq;
                const f32x4 ba = *(const f32x4*)(b_in + ch), bg = *(const f32x4*)(b_in + 512 + ch);
#pragma unroll
                for (int ai = 0; ai < 2; ++ai)
#pragma unroll
                    for (int m = 0; m < 4; ++m) {
                        const int row = u.pm * 256 + ai * 128 + wr * 64 + m * 16 + fr;
                        const f32x4 av = acc[ai][bj][m][0] + ba, gv = acc[ai][bj][m][1] + bg; f32x4 uv;
#pragma unroll
                        for (int e = 0; e < 4; ++e) uv[e] = av[e] * fsigmoid(gv[e]);
                        u32x2 w; w.x = pk2(uv[0], uv[1]); w.y = pk2(uv[2], uv[3]);
                        *(u32x2*)(U + (size_t)row * DC + ch) = w;
                        if (row < NPT) { const int t = row & (SEQ - 1); if (t >= SEQ - 30) *(f32x4*)(out + OCP + ((size_t)(row >> 11) * 30 + (t - (SEQ - 30))) * 512 + ch) = uv; }
                        else { const int s = row - NPT; *(f32x4*)(out + OCS + ((size_t)(s >> 2) * 30 + 26 + (s & 3)) * 512 + ch) = uv; }
                    }
            }
        } else {
#pragma unroll
            for (int bj = 0; bj < 2; ++bj)
#pragma unroll
                for (int n = 0; n < 2; ++n) {
                    const int pc = 256 * (u.pn - 4) + 128 * bj + 32 * wc + 16 * n + 4 * fq;
                    const f32x4 bp = *(const f32x4*)(b_in + 1024 + pc);
#pragma unroll
                    for (int ai = 0; ai < 2; ++ai)
#pragma unroll
                        for (int m = 0; m < 4; ++m) {
                            const int row = u.pm * 256 + ai * 128 + wr * 64 + m * 16 + fr;
                            const f32x4 pv = acc[ai][bj][m][n] + bp;
                            u32x2 w; w.x = pk2(pv[0], pv[1]); w.y = pk2(pv[2], pv[3]);
                            *(u32x2*)(P + (size_t)row * DC + pc) = w;
                            if (row < NPT) { const int t = row & (SEQ - 1); if (t >= SEQ - 15) *(f32x4*)(out + OPP + ((size_t)(row >> 11) * 15 + (t - (SEQ - 15))) * 512 + pc) = pv; }
                            else { const int s = row - NPT; *(f32x4*)(out + OPS + ((size_t)(s >> 2) * 15 + 11 + (s & 3)) * 512 + pc) = pv; }
                        }
                }
        }
    }
};
struct EpiKV {
    static constexpr bool PERM = false, AFTER_DRAIN = false;
    float* out; bf16_t* KB; bf16_t* VT;
    __device__ __forceinline__ void operator()(const f32x4 (&acc)[2][2][4][2], const Unit& u, int wr, int wc, int fr, int fq) const {
#pragma unroll
        for (int bj = 0; bj < 2; ++bj)
#pragma unroll
            for (int n = 0; n < 2; ++n) {
                const int col = u.pn * 256 + 128 * bj + 32 * wc + 16 * n + 4 * fq;
#pragma unroll
                for (int ai = 0; ai < 2; ++ai)
#pragma unroll
                    for (int m = 0; m < 4; ++m) {
                        const int row = u.pm * 256 + ai * 128 + wr * 64 + m * 16 + fr;
                        const f32x4 v = acc[ai][bj][m][n];
                        if (u.pn < 4) {
                            *(f32x4*)(out + OMK + (size_t)row * DM + col) = v;
                            u32x2 w; w.x = pk2(v[0], v[1]); w.y = pk2(v[2], v[3]);
                            *(u32x2*)(KB + (size_t)row * DM + col) = w;
                        } else {
                            const int c = col - DM;
                            *(f32x4*)(out + OMV + (size_t)row * DM + c) = v;
                            const int b = row >> 8, key = row & 255, h = c >> 8, d = c & 255;
                            bf16_t* vt = VT + ((size_t)((b * 4 + h) * 256 + d)) * 256 + key;
                            const unsigned w0 = pk2(v[0], v[1]), w1 = pk2(v[2], v[3]);
                            vt[0] = (bf16_t)(w0 & 0xffffu); vt[256] = (bf16_t)(w0 >> 16); vt[512] = (bf16_t)(w1 & 0xffffu); vt[768] = (bf16_t)(w1 >> 16);
                        }
                    }
            }
    }
};
template <int MODE, bool HAS_F32, bool HAS_BF, bool HAS_STATS, bool HAS_BIAS>
struct EpiRes {
    static constexpr bool PERM = false, AFTER_DRAIN = false;
    const bf16_t* xb; const float* stp; const float* g; const float* b;
    float* Rout; bf16_t* Rb; float* st; const float* bias;
    __device__ __forceinline__ void operator()(const f32x4 (&acc)[2][2][4][2], const Unit& u, int wr, int wc, int fr, int fq) const {
        const int colb = u.pn * 256 + 32 * wc + 4 * fq;
        f32x4 g4[2][2], b4[2][2], bi4[2][2];
#pragma unroll
        for (int bj = 0; bj < 2; ++bj)
#pragma unroll
            for (int n = 0; n < 2; ++n) { const int col = colb + 128 * bj + 16 * n;
                if (MODE == 1) { g4[bj][n] = *(const f32x4*)(g + col); b4[bj][n] = *(const f32x4*)(b + col); }
                if (HAS_BIAS) bi4[bj][n] = *(const f32x4*)(bias + col); }
#pragma unroll
        for (int ai = 0; ai < 2; ++ai)
#pragma unroll
            for (int m = 0; m < 4; ++m) {
                const int row = u.pm * 256 + ai * 128 + wr * 64 + m * 16 + fr;
                float mu = 0.f, rs = 1.f;
                if (MODE == 1) { const f32x2v s2 = *(const f32x2v*)(stp + 2 * row); mu = s2.x * (1.0f / DM); rs = rsqrtf(fmaxf(s2.y * (1.0f / DM) - mu * mu, 0.f) + LN_EPS); }
                const bf16_t* xrow = xb + (size_t)row * DM;
                float sum = 0.f, sq = 0.f;
#pragma unroll
                for (int bj = 0; bj < 2; ++bj)
#pragma unroll
                    for (int n = 0; n < 2; ++n) { const int col = colb + 128 * bj + 16 * n;
                        const u32x2 xw = *(const u32x2*)(xrow + col); f32x4 xv = {bflo(xw.x), bfhi(xw.x), bflo(xw.y), bfhi(xw.y)};
                        if (MODE == 1) xv = (xv - mu) * rs * g4[bj][n] + b4[bj][n];
                        f32x4 r = xv * DN_ALPHA + acc[ai][bj][m][n];
                        if (HAS_BIAS) r = r + bi4[bj][n];
                        if (HAS_F32) *(f32x4*)(Rout + (size_t)row * DM + col) = r;
                        if (HAS_BF) { u32x2 w; w.x = pk2(r[0], r[1]); w.y = pk2(r[2], r[3]); *(u32x2*)(Rb + (size_t)row * DM + col) = w; }
                        if (HAS_STATS) { sum += (r[0] + r[1]) + (r[2] + r[3]); sq += (r[0] * r[0] + r[1] * r[1]) + (r[2] * r[2] + r[3] * r[3]); }
                    }
                if (HAS_STATS) {
                    sum += __shfl_xor(sum, 16); sum += __shfl_xor(sum, 32); sq += __shfl_xor(sq, 16); sq += __shfl_xor(sq, 32);
                    if (fq == 0) { atomicAdd(st + 2 * row, sum); atomicAdd(st + 2 * row + 1, sq); }
                }
            }
    }
};
template <int ACT  , bool HAS_BIAS>
struct EpiFold {
    static constexpr bool PERM = true, AFTER_DRAIN = false;
    bf16_t* O; int ldc; const float* stp; const float* c1; const float* c2; const float* bias; float scale;
    __device__ __forceinline__ void operator()(const f32x4 (&acc)[2][2][4][2], const Unit& u, int wr, int wc, int fr, int fq) const {
        const int colb = u.pn * 256 + 32 * wc + 8 * fq;
        f32x4 c1v[2][2], c2v[2][2];
#pragma unroll
        for (int bj = 0; bj < 2; ++bj)
#pragma unroll
            for (int n = 0; n < 2; ++n) { const int col = colb + 128 * bj + 4 * n; c1v[bj][n] = *(const f32x4*)(c1 + col); c2v[bj][n] = *(const f32x4*)(c2 + col);
                if (HAS_BIAS) c2v[bj][n] = c2v[bj][n] + *(const f32x4*)(bias + col); }
#pragma unroll
        for (int ai = 0; ai < 2; ++ai)
#pragma unroll
            for (int m = 0; m < 4; ++m) {
                const int row = u.pm * 256 + ai * 128 + wr * 64 + m * 16 + fr;
                const f32x2v s2 = *(const f32x2v*)(stp + 2 * row); const float mu = s2.x * (1.0f / DM); const float rs = rsqrtf(fmaxf(s2.y * (1.0f / DM) - mu * mu, 0.f) + LN_EPS);
#pragma unroll
                for (int bj = 0; bj < 2; ++bj) {
                    f32x4 v0 = (acc[ai][bj][m][0] - c1v[bj][0] * mu) * rs + c2v[bj][0], v1 = (acc[ai][bj][m][1] - c1v[bj][1] * mu) * rs + c2v[bj][1];
                    if (ACT == 1) {
#pragma unroll
                        for (int e = 0; e < 4; ++e) { const float a = fmaxf(v0[e], 0.f), c = fmaxf(v1[e], 0.f); v0[e] = a * a; v1[e] = c * c; }
                    }
                    v0 = v0 * scale; v1 = v1 * scale;
                    u32x4 w; w.x = pk2(v0[0], v0[1]); w.y = pk2(v0[2], v0[3]); w.z = pk2(v1[0], v1[1]); w.w = pk2(v1[2], v1[3]);
                    *(u32x4*)(O + (size_t)row * ldc + colb + 128 * bj) = w;
                }
            }
    }
};

constexpr int SG_STRIDE = 528, SG_BOFF = 64 * SG_STRIDE;
template <class Epi>
__device__ __forceinline__ void small_gemm_phase(LAS unsigned char* lds, const bf16_t* A, const bf16_t* Bt, int K, int ld, int ncol64, const Epi& E, int first, int nblk, int bid, int tid) {
    const int lane = tid & 63, wid = tid >> 6, fr = lane & 15, fq = lane >> 4, mt = wid >> 1, nh = wid & 1;
    const int ub = bid - first; if (ub < 0 || ub >= nblk) return;
    const int nch = K >> 8;
    for (int u = ub; u < 8 * ncol64; u += nblk) {
        const int rt = u & 7, ct = u >> 3;
        const int row0 = NPT + 64 * rt, col0 = 64 * ct;
        u32x4 ra[4], rb[4];
#define SG_LOAD(kc) do { _Pragma("unroll") for (int i_ = 0; i_ < 4; ++i_) { const int idx_ = tid + 512 * i_; \
            ra[i_] = *(const u32x4*)(A + (size_t)(row0 + (idx_ >> 5)) * ld + (kc) * 256 + (idx_ & 31) * 8); rb[i_] = *(const u32x4*)(Bt + (size_t)(col0 + (idx_ >> 5)) * ld + (kc) * 256 + (idx_ & 31) * 8); } } while (0)
        SG_LOAD(0);
        f32x4 acc0 = {0.f, 0.f, 0.f, 0.f}, acc1 = {0.f, 0.f, 0.f, 0.f};
        const LAS unsigned char* apl = lds + (16 * mt + fr) * SG_STRIDE + 16 * fq;
        const LAS unsigned char* bpl = lds + SG_BOFF + (32 * nh + fr) * SG_STRIDE + 16 * fq;
#pragma unroll 1
        for (int kc = 0; kc < nch; ++kc) {
            __syncthreads();
#pragma unroll
            for (int i = 0; i < 4; ++i) { const int idx = tid + 512 * i; *(LAS u32x4*)(lds + (idx >> 5) * SG_STRIDE + (idx & 31) * 16) = ra[i]; *(LAS u32x4*)(lds + SG_BOFF + (idx >> 5) * SG_STRIDE + (idx & 31) * 16) = rb[i]; }
            if (kc + 1 < nch) SG_LOAD(kc + 1);
            __syncthreads();
#pragma unroll
            for (int s8 = 0; s8 < 8; ++s8) {
                const bf16x8 a = *(const LAS bf16x8*)(apl + s8 * 64), b0 = *(const LAS bf16x8*)(bpl + s8 * 64), b1 = *(const LAS bf16x8*)(bpl + 16 * SG_STRIDE + s8 * 64);
                acc0 = __builtin_amdgcn_mfma_f32_16x16x32_bf16(b0, a, acc0, 0, 0, 0);
                acc1 = __builtin_amdgcn_mfma_f32_16x16x32_bf16(b1, a, acc1, 0, 0, 0);
            }
        }
#undef SG_LOAD
        E(row0 + 16 * mt + fr, col0 + 32 * nh, fq, acc0, acc1);
    }
    __syncthreads();
}
struct SmallIn {
    const float* b_in; bf16_t* U; bf16_t* P; float* out;
    __device__ __forceinline__ void operator()(int row, int colb, int fq, f32x4 acc0, f32x4 acc1) const {
        const int s = row - NPT;
        if (colb < 1024) {
            const int ch = 16 * (colb >> 5) + 4 * fq;
            const f32x4 av = acc0 + *(const f32x4*)(b_in + ch), gv = acc1 + *(const f32x4*)(b_in + 512 + ch); f32x4 uv;
#pragma unroll
            for (int e = 0; e < 4; ++e) uv[e] = av[e] * fsigmoid(gv[e]);
            u32x2 w; w.x = pk2(uv[0], uv[1]); w.y = pk2(uv[2], uv[3]);
            *(u32x2*)(U + (size_t)row * DC + ch) = w;
            *(f32x4*)(out + OCS + ((size_t)(s >> 2) * 30 + 26 + (s & 3)) * 512 + ch) = uv;
        } else {
#pragma unroll
            for (int t = 0; t < 2; ++t) { const int pc = colb - 1024 + 16 * t + 4 * fq; const f32x4 pv = (t ? acc1 : acc0) + *(const f32x4*)(b_in + 1024 + pc);
                u32x2 w; w.x = pk2(pv[0], pv[1]); w.y = pk2(pv[2], pv[3]);
                *(u32x2*)(P + (size_t)row * DC + pc) = w;
                *(f32x4*)(out + OPS + ((size_t)(s >> 2) * 15 + 11 + (s & 3)) * 512 + pc) = pv; }
        }
    }
};
template <int MODE, bool HAS_F32, bool HAS_BF, bool HAS_STATS, bool HAS_BIAS>
struct SmallRes {
    const bf16_t* xb; const float* stp; const float* g; const float* b;
    float* Rout; bf16_t* Rb; float* st; const float* bias;
    __device__ __forceinline__ void operator()(int row, int colb, int fq, f32x4 acc0, f32x4 acc1) const {
        float mu = 0.f, rs = 1.f;
        if (MODE == 1) { const f32x2v s2 = *(const f32x2v*)(stp + 2 * row); mu = s2.x * (1.0f / DM); rs = rsqrtf(fmaxf(s2.y * (1.0f / DM) - mu * mu, 0.f) + LN_EPS); }
        const bf16_t* xrow = xb + (size_t)row * DM;
        float sum = 0.f, sq = 0.f;
#pragma unroll
        for (int t = 0; t < 2; ++t) { const int col = colb + 16 * t + 4 * fq;
            const u32x2 xw = *(const u32x2*)(xrow + col); f32x4 xv = {bflo(xw.x), bfhi(xw.x), bflo(xw.y), bfhi(xw.y)};
            if (MODE == 1) xv = (xv - mu) * rs * *(const f32x4*)(g + col) + *(const f32x4*)(b + col);
            f32x4 r = xv * DN_ALPHA + (t ? acc1 : acc0);
            if (HAS_BIAS) r = r + *(const f32x4*)(bias + col);
            if (HAS_F32) *(f32x4*)(Rout + (size_t)row * DM + col) = r;
            if (HAS_BF) { u32x2 w; w.x = pk2(r[0], r[1]); w.y = pk2(r[2], r[3]); *(u32x2*)(Rb + (size_t)row * DM + col) = w; }
            if (HAS_STATS) { sum += (r[0] + r[1]) + (r[2] + r[3]); sq += (r[0] * r[0] + r[1] * r[1]) + (r[2] * r[2] + r[3] * r[3]); } }
        if (HAS_STATS) {
            sum += __shfl_xor(sum, 16); sum += __shfl_xor(sum, 32); sq += __shfl_xor(sq, 16); sq += __shfl_xor(sq, 32);
            if (fq == 0) { atomicAdd(st + 2 * row, sum); atomicAdd(st + 2 * row + 1, sq); }
        }
    }
};
template <int ACT, bool HAS_BIAS>
struct SmallFold {
    bf16_t* O; int ldc; const float* stp; const float* c1; const float* c2; const float* bias; float scale;
    __device__ __forceinline__ void operator()(int row, int colb, int fq, f32x4 acc0, f32x4 acc1) const {
        const f32x2v s2 = *(const f32x2v*)(stp + 2 * row); const float mu = s2.x * (1.0f / DM); const float rs = rsqrtf(fmaxf(s2.y * (1.0f / DM) - mu * mu, 0.f) + LN_EPS);
#pragma unroll
        for (int t = 0; t < 2; ++t) { const int col = colb + 16 * t + 4 * fq;
            f32x4 c2v = *(const f32x4*)(c2 + col); if (HAS_BIAS) c2v = c2v + *(const f32x4*)(bias + col);
            f32x4 v = ((t ? acc1 : acc0) - *(const f32x4*)(c1 + col) * mu) * rs + c2v;
            if (ACT == 1) {
#pragma unroll
                for (int e = 0; e < 4; ++e) { const float a = fmaxf(v[e], 0.f); v[e] = a * a; }
            }
            v = v * scale;
            u32x2 w; w.x = pk2(v[0], v[1]); w.y = pk2(v[2], v[3]);
            *(u32x2*)(O + (size_t)row * ldc + col) = w; }
    }
};

__device__ __forceinline__ void gn_swish_store(float v0, float v1, f32x2v gg, f32x2v gb, unsigned* dst) {
    float s = v0 + v1;
#pragma unroll
    for (int o = 1; o < 32; o <<= 1) s += __shfl_xor(s, o);
    const float mean = s * (1.0f / 64.0f); const float d0 = v0 - mean, d1 = v1 - mean;
    float q = d0 * d0 + d1 * d1;
#pragma unroll
    for (int o = 1; o < 32; o <<= 1) q += __shfl_xor(q, o);
    const float rstd = rsqrtf(q * (1.0f / 64.0f) + LN_EPS);
    float y0 = d0 * rstd * gg.x + gb.x, y1 = d1 * rstd * gg.y + gb.y;
    y0 = y0 * fsigmoid(y0); y1 = y1 * fsigmoid(y1);
    *dst = pk2(y0, y1);
}
__device__ __forceinline__ f32x2v bf2(unsigned v) { return (f32x2v){bflo(v), bfhi(v)}; }
template <int W>
__device__ __forceinline__ void pool_prompt_w(const unsigned (&pin)[31], int t0, unsigned* dst  ) {
    f32x2v s = {0.f, 0.f};
#pragma unroll
    for (int i = 0; i < W; ++i) s = s + bf2(pin[15 - i]);
#pragma unroll
    for (int t = 0; t < 16; ++t) {
        if (t > 0) s = s + (bf2(pin[15 + t]) - bf2(pin[15 + t - W]));
        const float cnt = (float)min(t0 + t + 1, W); const f32x2v cur = bf2(pin[15 + t]);
        dst[(size_t)t * 512] = pk2(s.x / cnt - cur.x, s.y / cnt - cur.y);
    }
}
__device__ __forceinline__ void mixer_prompt_run(const Args& p, int run, int c2) {
    const int b = run >> 7, t0 = (run & 127) * 16;
    const unsigned* U32 = (const unsigned*)p.U(); const unsigned* P32 = (const unsigned*)p.P(); unsigned* M32 = (unsigned*)p.MIX();
    const size_t rowb = (size_t)b * SEQ;
    {
        unsigned pin[31];
#pragma unroll
        for (int i = 0; i < 31; ++i) { const int t = t0 - 15 + i; const unsigned v = P32[(rowb + (t >= 0 ? t : 0)) * 256 + c2]; pin[i] = (t >= 0) ? v : 0u; }
        const int gi = __builtin_amdgcn_readfirstlane(c2 >> 6);
        unsigned* dst = M32 + (rowb + t0) * 512 + 256 + c2;
        if (gi == 0) pool_prompt_w<2>(pin, t0, dst); else if (gi == 1) pool_prompt_w<4>(pin, t0, dst); else if (gi == 2) pool_prompt_w<8>(pin, t0, dst); else pool_prompt_w<16>(pin, t0, dst);
    }
    asm volatile("" ::: "memory");
    {
        f32x2v w[31];
#pragma unroll
        for (int j = 0; j < 31; ++j) w[j] = *(const f32x2v*)(p.conv_w() + j * 512 + 2 * c2);
        const f32x2v cb = *(const f32x2v*)(p.conv_b() + 2 * c2);
        const f32x2v gg = *(const f32x2v*)(p.gn_g() + 2 * c2), gb = *(const f32x2v*)(p.gn_b() + 2 * c2);
#pragma unroll 1
        for (int hh = 0; hh < 2; ++hh) {
            f32x2v a[8];
#pragma unroll
            for (int t = 0; t < 8; ++t) a[t] = cb;
#pragma unroll
            for (int i = 0; i < 38; ++i) {
                const int ti = t0 + 8 * hh - 30 + i; unsigned v = U32[(rowb + (ti >= 0 ? ti : 0)) * 256 + c2]; v = (ti >= 0) ? v : 0u; const f32x2v x = bf2(v);
#pragma unroll
                for (int t = 0; t < 8; ++t) { const int j = i - t; if (j >= 0 && j <= 30) a[t] = w[j] * x + a[t]; }
                if (i == 18) asm volatile("" ::: "memory");
            }
#pragma unroll
            for (int t = 0; t < 8; ++t) gn_swish_store(a[t].x, a[t].y, gg, gb, M32 + (rowb + t0 + 8 * hh + t) * 512 + c2);
            asm volatile("" ::: "memory");
        }
    }
}
__device__ __forceinline__ void mixer_sample_run(const Args& p, int sb, int c2) {
    const unsigned* U32 = (const unsigned*)p.U(); const unsigned* P32 = (const unsigned*)p.P(); unsigned* M32 = (unsigned*)p.MIX();
    const size_t rowb = (size_t)NPT + (size_t)sb * DECS;
    {
        float w0[31], w1[31];
#pragma unroll
        for (int j = 0; j < 31; ++j) { const f32x2v w = *(const f32x2v*)(p.conv_w() + j * 512 + 2 * c2); w0[j] = w.x; w1[j] = w.y; }
        const f32x2v cb = *(const f32x2v*)(p.conv_b() + 2 * c2);
        float a0[4], a1[4];
#pragma unroll
        for (int t = 0; t < 4; ++t) { a0[t] = cb.x; a1[t] = cb.y; }
#pragma unroll
        for (int i = 0; i < 34; ++i) {
            float x0, x1;
            if (i < 30) { const f32x2v v = *(const f32x2v*)(p.state_conv() + ((size_t)sb * 30 + i) * 512 + 2 * c2); x0 = v.x; x1 = v.y; }
            else { const unsigned v = U32[(rowb + (i - 30)) * 256 + c2]; x0 = bflo(v); x1 = bfhi(v); }
#pragma unroll
            for (int t = 0; t < 4; ++t) { const int j = i - t; if (j >= 0 && j <= 30) { a0[t] = fmaf(w0[j], x0, a0[t]); a1[t] = fmaf(w1[j], x1, a1[t]); } }
        }
        const f32x2v gg = *(const f32x2v*)(p.gn_g() + 2 * c2), gb = *(const f32x2v*)(p.gn_b() + 2 * c2);
#pragma unroll
        for (int t = 0; t < 4; ++t) gn_swish_store(a0[t], a1[t], gg, gb, M32 + (rowb + t) * 512 + c2);
    }
    {
        float q0[19], q1[19];
#pragma unroll
        for (int i = 0; i < 15; ++i) { const f32x2v v = *(const f32x2v*)(p.state_pool() + ((size_t)sb * 15 + i) * 512 + 2 * c2); q0[i] = v.x; q1[i] = v.y; }
#pragma unroll
        for (int t = 0; t < 4; ++t) { const unsigned v = P32[(rowb + t) * 256 + c2]; q0[15 + t] = bflo(v); q1[15 + t] = bfhi(v); }
        const int w = 2 << (c2 >> 6); const float cnt = (float)w;
#pragma unroll
        for (int t = 0; t < 4; ++t) { float s0 = 0.f, s1 = 0.f;
#pragma unroll
            for (int i = 0; i < 16; ++i) { if (i < w) { s0 += q0[15 + t - i]; s1 += q1[15 + t - i]; } }
            M32[(rowb + t) * 512 + 256 + c2] = pk2(s0 / cnt - q0[15 + t], s1 / cnt - q1[15 + t]); }
    }
}
__device__ __forceinline__ void p2_mixer(const Args& p, int G, int bid, int tid) {
    const int half = __builtin_amdgcn_readfirstlane(tid >> 8), c2 = tid & 255;
    for (int it = bid; it < 512 + 64; it += G) {
        if (it < 512) mixer_prompt_run(p, 2 * it + half, c2);
        else mixer_sample_run(p, 2 * (it - 512) + half, c2);
    }
}

#define MFMA32(a, b, c) __builtin_amdgcn_mfma_f32_32x32x16_bf16((a), (b), (c), 0, 0, 0)
constexpr int AT_STRIDE = 528;
__device__ __forceinline__ void attn_prompt_unit(const Args& p, LAS unsigned char* lds, int unit, int tid) {
    const int lane = tid & 63, wid = tid >> 6, r = lane & 31, hi = lane >> 5;
    const int b = unit >> 5, h = (unit >> 3) & 3, qb = unit & 7;
    const size_t qrow = (size_t)b * SEQ + qb * 256 + wid * 32 + r;
    bf16x8 qf[8];
    LAS bf16x8* qlds = (LAS bf16x8*)(lds + 17408 + wid * 8192) + lane;
    { const bf16_t* qp = p.Q() + qrow * DM + h * 256 + 8 * hi;
#pragma unroll
      for (int ks = 0; ks < 8; ++ks) qf[ks] = *(const bf16x8*)(qp + ks * 16);
#pragma unroll
      for (int ks = 0; ks < 8; ++ks) qlds[ks * 64] = *(const bf16x8*)(qp + (8 + ks) * 16); }
    const bf16_t* kbase = p.KB() + (size_t)(b * NMEM) * DM + h * 256;
    const bf16_t* vbase = p.VT() + (size_t)((b * 4 + h) * 256) * 256;
    u32x4 stg[2];
    f32x16 st[8];
#pragma unroll
    for (int t = 0; t < 8; ++t)
#pragma unroll
        for (int i = 0; i < 16; ++i) st[t][i] = 0.f;
#define AT_LOADK(kt) do { _Pragma("unroll") for (int i_ = 0; i_ < 2; ++i_) { const int idx_ = tid + 512 * i_; stg[i_] = *(const u32x4*)(kbase + (size_t)((kt) * 32 + (idx_ >> 5)) * DM + (idx_ & 31) * 8); } } while (0)
#define AT_LOADV(dt) do { _Pragma("unroll") for (int i_ = 0; i_ < 2; ++i_) { const int idx_ = tid + 512 * i_; stg[i_] = *(const u32x4*)(vbase + (size_t)((dt) * 32 + (idx_ >> 5)) * 256 + (idx_ & 31) * 8); } } while (0)
#define AT_WRITE() do { _Pragma("unroll") for (int i_ = 0; i_ < 2; ++i_) { const int idx_ = tid + 512 * i_; *(LAS u32x4*)(lds + (idx_ >> 5) * AT_STRIDE + (idx_ & 31) * 16) = stg[i_]; } } while (0)
    AT_LOADK(0);
#pragma unroll
    for (int kt = 0; kt < 8; ++kt) {
        __syncthreads();
        AT_WRITE();
        if (kt < 7) AT_LOADK(kt + 1); else AT_LOADV(0);
        __syncthreads();
        const LAS unsigned char* ap = lds + r * AT_STRIDE + hi * 16;
#pragma unroll
        for (int ks = 0; ks < 8; ++ks) { const bf16x8 a = *(const LAS bf16x8*)(ap + ks * 32); st[kt] = MFMA32(a, qf[ks], st[kt]); }
#pragma unroll
        for (int ks = 0; ks < 8; ++ks) { const bf16x8 a = *(const LAS bf16x8*)(ap + (8 + ks) * 32); const bf16x8 qb8 = qlds[ks * 64]; st[kt] = MFMA32(a, qb8, st[kt]); }
    }
    float mx = -3.0e38f;
#pragma unroll
    for (int t = 0; t < 8; ++t)
#pragma unroll
        for (int i = 0; i < 16; ++i) mx = fmaxf(mx, st[t][i]);
    mx = fmaxf(mx, __shfl_xor(mx, 32));
    float sum = 0.f;
#pragma unroll
    for (int t = 0; t < 8; ++t)
#pragma unroll
        for (int i = 0; i < 16; ++i) { const float e = __expf(st[t][i] - mx); st[t][i] = e; sum += e; }
    sum += __shfl_xor(sum, 32);
    const float inv = 1.0f / sum;
    bf16x8 pf[16];
#pragma unroll
    for (int t = 0; t < 8; ++t)
#pragma unroll
        for (int s = 0; s < 2; ++s) { u32x4 w; w.x = pk2(st[t][8 * s + 0], st[t][8 * s + 1]); w.y = pk2(st[t][8 * s + 2], st[t][8 * s + 3]); w.z = pk2(st[t][8 * s + 4], st[t][8 * s + 5]); w.w = pk2(st[t][8 * s + 6], st[t][8 * s + 7]);
            pf[2 * t + s] = __builtin_bit_cast(bf16x8, w); }
    bf16_t* orow = p.O() + qrow * DM + h * 256;
#pragma unroll
    for (int dt = 0; dt < 8; ++dt) {
        __syncthreads();
        AT_WRITE();
        if (dt < 7) AT_LOADV(dt + 1);
        __syncthreads();
        f32x16 o;
#pragma unroll
        for (int i = 0; i < 16; ++i) o[i] = 0.f;
        const LAS unsigned char* ap = lds + r * AT_STRIDE + hi * 8;
#pragma unroll
        for (int s16 = 0; s16 < 16; ++s16) { const s16x4 lo = *(const LAS s16x4*)(ap + s16 * 32), hh = *(const LAS s16x4*)(ap + s16 * 32 + 16);
            const bf16x8 a = __builtin_shufflevector(lo, hh, 0, 1, 2, 3, 4, 5, 6, 7); o = MFMA32(a, pf[s16], o); }
#pragma unroll
        for (int g4 = 0; g4 < 4; ++g4) { const int d = dt * 32 + 8 * g4 + 4 * hi;
            u32x2 w; w.x = pk2(o[4 * g4 + 0] * inv, o[4 * g4 + 1] * inv); w.y = pk2(o[4 * g4 + 2] * inv, o[4 * g4 + 3] * inv);
            *(u32x2*)(orow + d) = w; }
    }
    __syncthreads();
#undef AT_LOADK
#undef AT_LOADV
#undef AT_WRITE
}
__device__ __forceinline__ void attn_sample_unit(const Args& p, LAS unsigned char* lds, int unit, int tid) {
    const int lane = tid & 63, wid = tid >> 6;
    const int sb = unit >> 2, h = unit & 3;
    LAS float* S = (LAS float*)lds;
    LAS float* RED = (LAS float*)(lds + 4096);
    const size_t row0 = (size_t)NPT + (size_t)sb * DECS;
    f32x4 qv[4];
#pragma unroll
    for (int i = 0; i < 4; ++i) { const u32x2 w = *(const u32x2*)(p.Q() + (row0 + i) * DM + h * 256 + 4 * lane); qv[i] = (f32x4){bflo(w.x), bfhi(w.x), bflo(w.y), bfhi(w.y)}; }
    const float* kp = p.cache_k() + ((size_t)sb * NMEM * 4 + h) * 256 + 4 * lane;
    const float* vp = p.cache_v() + ((size_t)sb * NMEM * 4 + h) * 256 + 4 * lane;
    const int qi = ((lane & 1) << 1) | ((lane >> 1) & 1);
    f32x4 kv[8], kn[8];
#pragma unroll
    for (int j = 0; j < 8; ++j) kv[j] = *(const f32x4*)(kp + (size_t)(wid * 32 + j) * DM);
#pragma unroll 1
    for (int kk = 0; kk < 4; ++kk) {
        if (kk < 3) {
#pragma unroll
            for (int j = 0; j < 8; ++j) kn[j] = *(const f32x4*)(kp + (size_t)(wid * 32 + (kk + 1) * 8 + j) * DM);
        }
#pragma unroll
        for (int j = 0; j < 8; ++j) {
            float d[4];
#pragma unroll
            for (int i = 0; i < 4; ++i) d[i] = (kv[j][0] * qv[i][0] + kv[j][1] * qv[i][1]) + (kv[j][2] * qv[i][2] + kv[j][3] * qv[i][3]);
            const bool o1 = lane & 1, o2 = lane & 2;
            float k0 = o1 ? d[2] : d[0], k1 = o1 ? d[3] : d[1]; const float s0 = o1 ? d[0] : d[2], s1 = o1 ? d[1] : d[3];
            k0 += __shfl_xor(s0, 1); k1 += __shfl_xor(s1, 1);
            float kq = o2 ? k1 : k0; const float sq = o2 ? k0 : k1;
            kq += __shfl_xor(sq, 2);
            kq += __shfl_xor(kq, 4); kq += __shfl_xor(kq, 8); kq += __shfl_xor(kq, 16); kq += __shfl_xor(kq, 32);
            if (lane < 4) S[(wid * 32 + kk * 8 + j) * 4 + qi] = kq;
        }
#pragma unroll
        for (int j = 0; j < 8; ++j) kv[j] = kn[j];
    }
#pragma unroll
    for (int j = 0; j < 8; ++j) kv[j] = *(const f32x4*)(vp + (size_t)(wid * 32 + j) * DM);
    __syncthreads();
    if (wid < 4) {
        float s[4]; float mx = -3.0e38f;
#pragma unroll
        for (int j = 0; j < 4; ++j) { s[j] = S[(lane + 64 * j) * 4 + wid]; mx = fmaxf(mx, s[j]); }
        mx = wave_max(mx); float sum = 0.f;
#pragma unroll
        for (int j = 0; j < 4; ++j) { s[j] = __expf(s[j] - mx); sum += s[j]; }
        sum = wave_sum(sum); const float inv = 1.0f / sum;
#pragma unroll
        for (int j = 0; j < 4; ++j) S[(lane + 64 * j) * 4 + wid] = s[j] * inv;
    }
    __syncthreads();
    f32x4 acc[4];
#pragma unroll
    for (int i = 0; i < 4; ++i) acc[i] = (f32x4){0.f, 0.f, 0.f, 0.f};
#pragma unroll 1
    for (int kk = 0; kk < 4; ++kk) {
        if (kk < 3) {
#pragma unroll
            for (int j = 0; j < 8; ++j) kn[j] = *(const f32x4*)(vp + (size_t)(wid * 32 + (kk + 1) * 8 + j) * DM);
        }
#pragma unroll
        for (int j = 0; j < 8; ++j) { const f32x4 pv = *(const LAS f32x4*)(S + (wid * 32 + kk * 8 + j) * 4);
#pragma unroll
            for (int i = 0; i < 4; ++i) acc[i] = acc[i] + kv[j] * pv[i]; }
#pragma unroll
        for (int j = 0; j < 8; ++j) kv[j] = kn[j];
    }
#pragma unroll
    for (int i = 0; i < 4; ++i) *(LAS f32x4*)(RED + (wid * 4 + i) * 256 + 4 * lane) = acc[i];
    __syncthreads();
    { const int i = tid >> 7, d = (tid & 127) * 2; float o0 = 0.f, o1 = 0.f;
#pragma unroll
      for (int w = 0; w < 8; ++w) { const f32x2v v = *(const LAS f32x2v*)(RED + (w * 4 + i) * 256 + d); o0 += v.x; o1 += v.y; }
      *(unsigned*)(p.O() + (row0 + i) * DM + h * 256 + d) = pk2(o0, o1); }
    __syncthreads();
}
__device__ __forceinline__ void p5_attention(const Args& p, LAS unsigned char* lds, int G, int bid, int tid) {
    const int vcu = (G % 8 == 0) ? (bid % 8) * (G / 8) + bid / 8 : bid;
    if (vcu & 1) { for (int u = vcu; u < DECB * 4; u += G) attn_sample_unit(p, lds, u, tid); }
    for (int u = vcu; u < NBATCH * 4 * 8; u += G) attn_prompt_unit(p, lds, u, tid);
    if (!(vcu & 1)) { for (int u = vcu; u < DECB * 4; u += G) attn_sample_unit(p, lds, u, tid); }
}

__device__ __forceinline__ void p9_ln3(const Args& p, int G, int bid, int tid) {
    const int lane = tid & 63, gw = bid * 8 + (tid >> 6), NGW = G * 8;
    f32x4 g4[4], b4[4];
#pragma unroll
    for (int j = 0; j < 4; ++j) { g4[j] = ((const f32x4*)p.ln3_g())[lane + 64 * j]; b4[j] = ((const f32x4*)p.ln3_b())[lane + 64 * j]; }
    for (int m0 = gw; m0 < MT; m0 += 2 * NGW) {
        const int m1 = (m0 + NGW < MT) ? m0 + NGW : m0;
        const f32x4* xi0 = (const f32x4*)(p.R1() + (size_t)m0 * DM) + lane; const f32x4* xi1 = (const f32x4*)(p.R1() + (size_t)m1 * DM) + lane;
        f32x4 v[2][4]; float s[2] = {0.f, 0.f};
#pragma unroll
        for (int j = 0; j < 4; ++j) { v[0][j] = xi0[64 * j]; v[1][j] = xi1[64 * j]; }
#pragma unroll
        for (int q = 0; q < 2; ++q)
#pragma unroll
            for (int j = 0; j < 4; ++j) s[q] += (v[q][j].x + v[q][j].y) + (v[q][j].z + v[q][j].w);
#pragma unroll
        for (int q = 0; q < 2; ++q) {
            const float mean = wave_sum(s[q]) * (1.0f / DM); float s2 = 0.f;
#pragma unroll
            for (int j = 0; j < 4; ++j) { v[q][j] = v[q][j] - mean; s2 += (v[q][j].x * v[q][j].x + v[q][j].y * v[q][j].y) + (v[q][j].z * v[q][j].z + v[q][j].w * v[q][j].w); }
            const float rstd = rsqrtf(wave_sum(s2) * (1.0f / DM) + LN_EPS);
            f32x4* xr = (f32x4*)(p.out() + OY + (size_t)(q ? m1 : m0) * DM) + lane;
#pragma unroll
            for (int j = 0; j < 4; ++j) xr[64 * j] = v[q][j] * rstd * g4[j] + b4[j];
        }
    }
}

#define GEMM_PHASE(EpiT, E, A_, B_, M_, N_, K_, c_) do { pg8::Gemm g_{A_, B_, M_, N_, K_}; pg8::StaticOrder S_; S_.init(M_, N_, G, c_); \
        pg8::gemm_phase<EpiT, pg8::StaticOrder, true, true>(lds, g_, S_, E); } while (0)

__global__ void __launch_bounds__(512, 2) fwd_megakernel(Args a) {
    extern __shared__ __attribute__((aligned(16))) unsigned char lds_raw[];
    LAS unsigned char* lds = (LAS unsigned char*)lds_raw;
    cg::grid_group grid = cg::this_grid();
    const int tid = threadIdx.x, bid = blockIdx.x, G = gridDim.x;
    const Args& p = a;
    volatile LAS unsigned* misc = (volatile LAS unsigned*)(lds + 131072 + 1024);
    if (tid < 2) misc[tid] = 0u;
    __syncthreads();
    const XcdBarrier bar = xcd_barrier_post((unsigned*)p.ctl() + CW_BAR, misc);
    const int lo = a.ph_lo, hi = a.ph_hi;
#ifndef PH_MASK
#define PH_MASK 0x3ff
#endif
#define IN(k) (((PH_MASK >> (k)) & 1) && lo <= (k) && (k) < hi)
#define SEAM(k) do { if ((k) + 1 < hi) xcd_barrier(bar); } while (0)
    if (lo < 0) grid.sync();

    if (IN(0)) { p0_prologue(p, lds, G, bid, tid); SEAM(0); }
    if (IN(1)) {
        { EpiIn E{p.b_in(), p.U(), p.P(), p.out()}; GEMM_PHASE(EpiIn, E, p.XB(), p.Win_t(), NPT, DIN, DM, bid); }
        { EpiKV E{p.out(), p.KB(), p.VT()}; const int rot = ((NPT / 256) * (DIN / 256)) % G; GEMM_PHASE(EpiKV, E, p.MB(), p.Wkv_t(), MEMROWS, 2 * DM, DM, (bid + G - rot) % G); }
        { SmallIn E{p.b_in(), p.U(), p.P(), p.out()}; small_gemm_phase(lds, p.XB(), p.Win_t(), DM, DM, DIN / 64, E, G - G / 4, G / 4, bid, tid); }
        SEAM(1);
    }
    if (IN(2)) { p2_mixer(p, G, bid, tid); SEAM(2); }
    if (IN(3)) { { typedef EpiRes<0, false, true, true, false> EpiT; EpiT E{p.XB(), nullptr, nullptr, nullptr, nullptr, p.R1B(), p.ctl() + CF_ST1, nullptr};
          GEMM_PHASE(EpiT, E, p.MIX(), p.Wout_t(), NPT, DM, DM, bid); }
        { SmallRes<0, false, true, true, false> E{p.XB(), nullptr, nullptr, nullptr, nullptr, p.R1B(), p.ctl() + CF_ST1, nullptr}; small_gemm_phase(lds, p.MIX(), p.Wout_t(), DM, DM, DM / 64, E, 0, G, bid, tid); }
        SEAM(3); }
    if (IN(4)) { { typedef EpiFold<0, false> EpiT; EpiT E{p.Q(), DM, p.ctl() + CF_ST1, p.ctl() + CF_C1Q, p.ctl() + CF_C2Q, nullptr, 0.0625f};
          GEMM_PHASE(EpiT, E, p.R1B(), p.Wq_t(), NPT, DM, DM, bid); }
        { SmallFold<0, false> E{p.Q(), DM, p.ctl() + CF_ST1, p.ctl() + CF_C1Q, p.ctl() + CF_C2Q, nullptr, 0.0625f}; small_gemm_phase(lds, p.R1B(), p.Wq_t(), DM, DM, DM / 64, E, 0, G, bid, tid); }
        SEAM(4); }
    if (IN(5)) { p5_attention(p, lds, G, bid, tid); SEAM(5); }
    if (IN(6)) { { typedef EpiRes<1, false, true, true, false> EpiT; EpiT E{p.R1B(), p.ctl() + CF_ST1, p.ln1_g(), p.ln1_b(), nullptr, p.R2B(), p.ctl() + CF_ST2, nullptr};
          GEMM_PHASE(EpiT, E, p.O(), p.Wo_t(), NPT, DM, DM, bid); }
        { SmallRes<1, false, true, true, false> E{p.R1B(), p.ctl() + CF_ST1, p.ln1_g(), p.ln1_b(), nullptr, p.R2B(), p.ctl() + CF_ST2, nullptr}; small_gemm_phase(lds, p.O(), p.Wo_t(), DM, DM, DM / 64, E, 0, G, bid, tid); }
        SEAM(6); }
    if (IN(7)) { { typedef EpiFold<1, true> EpiT; EpiT E{p.H(), DFF, p.ctl() + CF_ST2, p.ctl() + CF_C1H, p.ctl() + CF_C2H, p.b1(), 1.0f};
          GEMM_PHASE(EpiT, E, p.R2B(), p.W1_t(), NPT, DFF, DM, bid); }
        { SmallFold<1, true> E{p.H(), DFF, p.ctl() + CF_ST2, p.ctl() + CF_C1H, p.ctl() + CF_C2H, p.b1(), 1.0f}; small_gemm_phase(lds, p.R2B(), p.W1_t(), DM, DM, DFF / 64, E, 0, G, bid, tid); }
        SEAM(7); }
    if (IN(8)) { { typedef EpiRes<1, true, false, false, true> EpiT; EpiT E{p.R2B(), p.ctl() + CF_ST2, p.ln2_g(), p.ln2_b(), p.R1(), nullptr, nullptr, p.b2()};
          GEMM_PHASE(EpiT, E, p.H(), p.W2_t(), NPT, DM, DFF, bid); }
        { SmallRes<1, true, false, false, true> E{p.R2B(), p.ctl() + CF_ST2, p.ln2_g(), p.ln2_b(), p.R1(), nullptr, nullptr, p.b2()}; small_gemm_phase(lds, p.H(), p.W2_t(), DFF, DFF, DM / 64, E, 0, G, bid, tid); }
        SEAM(8); }
    if (IN(9)) { p9_ln3(p, G, bid, tid); }
#undef IN
#undef SEAM
}

extern "C" void kernel_launch(void* const* d_in, const int* in_sizes, int n_in, void* d_out, int out_size, void* d_ws, size_t ws_size, hipStream_t stream) {
    static int grid = 0;
    if (grid == 0) {
        if (n_in != 30 || (size_t)out_size != OEND || ws_size < WS_END) { fprintf(stderr, "kernel_launch: unexpected problem shape (n_in %d, out %d, ws %zu)\n", n_in, out_size, ws_size); grid = -1; return; }
        int dev = 0, cus = 0, per_cu = 0;
        if (hipGetDevice(&dev) != hipSuccess || hipDeviceGetAttribute(&cus, hipDeviceAttributeMultiprocessorCount, dev) != hipSuccess) { grid = -1; return; }
        if (hipFuncSetAttribute((const void*)fwd_megakernel, hipFuncAttributeMaxDynamicSharedMemorySize, LDS_BYTES) != hipSuccess) { fprintf(stderr, "kernel_launch: hipFuncSetAttribute failed\n"); grid = -1; return; }
        if (hipOccupancyMaxActiveBlocksPerMultiprocessor(&per_cu, (const void*)fwd_megakernel, 512, LDS_BYTES) != hipSuccess || per_cu < 1) { fprintf(stderr, "kernel_launch: occupancy query failed (%d)\n", per_cu); (void)hipGetLastError(); grid = -1; return; }
        grid = cus * per_cu;
    }
    if (grid < 0) return;
    (void)hipMemsetAsync((char*)d_ws + WS_CTL, 0, CTL_ZERO_BYTES, stream);
    Args a{};
    for (int i = 0; i < 30; ++i) a.in[i] = (const float*)d_in[i];
    a.outp = (float*)d_out; a.ws = (unsigned char*)d_ws;
#if MK_PER_PHASE
#ifndef EXTRA_MASK
#define EXTRA_MASK 0
#endif
    for (int ph = 0; ph < NPHASE; ++ph) { a.ph_lo = ph; a.ph_hi = ph + 1; hipLaunchKernelGGL(fwd_megakernel, dim3(grid), dim3(512), LDS_BYTES, stream, a);
        if ((EXTRA_MASK >> ph) & 1) {
            if (ph == 0) (void)hipMemsetAsync((char*)d_ws + WS_CTL, 0, CTL_ZERO_BYTES, stream);
            if (ph == 3) (void)hipMemsetAsync((char*)d_ws + WS_CTL + CF_ST1 * 4, 0, MT * 8, stream);
            if (ph == 6) (void)hipMemsetAsync((char*)d_ws + WS_CTL + CF_ST2 * 4, 0, MT * 8, stream);
            hipLaunchKernelGGL(fwd_megakernel, dim3(grid), dim3(512), LDS_BYTES, stream, a); } }
#else
    a.ph_lo = 0; a.ph_hi = NPHASE;
    void* args[] = {&a};
    hipError_t e = hipLaunchCooperativeKernel((const void*)fwd_megakernel, dim3(grid), dim3(512), args, LDS_BYTES, stream);
    if (e != hipSuccess) fprintf(stderr, "kernel_launch: cooperative launch failed: %s (grid %d)\n", hipGetErrorString(e), grid);
#endif
}
```
